# Optimizing an MI355X kernel written in HIP

```python
import math
import jax, jax.numpy as jnp
from jax import lax
import numpy as np

D_MODEL = 2048
BATCH = 4
SEQ = 2048
DEPTH = 4

DA_HEADS = 4
DA_QK_DIM = 64
DA_V_DIM = 128
Q_BLOCK = 128
HG_HEADS = 6
HG_K_DIM = 128
HG_V_DIM = 128
HG_CHUNK = 16
NSA_HEADS = 6
NSA_KV_HEADS = 2
NSA_GROUP = NSA_HEADS // NSA_KV_HEADS
NSA_DIM = 128
CMP_LEN = 32
CMP_STRIDE = 16
CMP_HIDDEN = 256
SLC_BLOCK = 64
SLC_TOPK = 16
SLC_Q_BLOCK = 64
WINDOW = 512
WIN_Q_BLOCK = 128
FORCE_BONUS = 1.0e4
D_A = DA_HEADS * DA_V_DIM
D_B = HG_HEADS * HG_V_DIM
D_C = NSA_HEADS * NSA_DIM
D_MIX = D_A + D_B + D_C
D_FF = ((8 * D_MODEL // 3 + 255) // 256) * 256
IN_SIZES = (
    DA_HEADS * 2 * DA_QK_DIM, DA_HEADS * 2 * DA_QK_DIM, D_A,
    HG_HEADS * HG_K_DIM, HG_HEADS * HG_K_DIM, D_B, D_B,
    D_C,
    NSA_KV_HEADS * NSA_DIM, NSA_KV_HEADS * NSA_DIM,
    NSA_KV_HEADS * NSA_DIM, NSA_KV_HEADS * NSA_DIM,
    NSA_KV_HEADS * NSA_DIM, NSA_KV_HEADS * NSA_DIM,
    NSA_HEADS * 3,
)
D_IN = sum(IN_SIZES)

kernel_name = "hymba_diffattn_hgrn2_nsa_trunk"


def rmsnorm(x, g, eps=1e-6):
    xf = x.astype(jnp.float32)
    y = xf * lax.rsqrt(jnp.mean(xf * xf, axis=-1, keepdims=True) + eps)
    return (y * g.astype(jnp.float32)).astype(x.dtype)


def masked_softmax(s, mask):
    s = jnp.where(mask, s.astype(jnp.float32), -jnp.inf)
    m = jnp.max(s, axis=-1, keepdims=True)
    m = jnp.where(jnp.isfinite(m), m, 0.0)
    p = jnp.exp(s - m)
    return p / jnp.maximum(jnp.sum(p, axis=-1, keepdims=True), 1e-30)


def diff_attention(q, k, v, lam):
    B, T = q.shape[:2]
    nblk = T // Q_BLOCK
    scale = DA_QK_DIM ** -0.5
    qb = jnp.moveaxis(q.reshape(B, nblk, Q_BLOCK, DA_HEADS, 2, DA_QK_DIM), 1, 0)
    kpos = jnp.arange(T)

    def block(args):
        qi, i = args
        s = jnp.einsum('bqhcd,bkhcd->bhcqk', qi, k) * scale
        qpos = i * Q_BLOCK + jnp.arange(Q_BLOCK)
        p = masked_softmax(s, kpos[None, :] <= qpos[:, None])
        pd = p[:, :, 0] - lam * p[:, :, 1]
        return jnp.einsum('bhqk,bkhd->bqhd', pd.astype(v.dtype), v)

    o = lax.map(block, (qb, jnp.arange(nblk)))
    return jnp.moveaxis(o, 0, 1).reshape(B, T, DA_HEADS, DA_V_DIM)


def hgrn2_mixer(f_logit, q, i, lb):
    B, T = f_logit.shape[:2]
    n = T // HG_CHUNK
    lb = lb.astype(jnp.float32).reshape(HG_HEADS, HG_K_DIM)
    logf = jnp.logaddexp(jnp.log(lb), jnp.log1p(-lb) + jax.nn.log_sigmoid(f_logit.astype(jnp.float32)))
    key = -jnp.expm1(logf)

    def to_chunks(a):
        return a.astype(jnp.float32).reshape(B, n, HG_CHUNK, HG_HEADS, -1).transpose(0, 3, 1, 2, 4)

    logf_c, q_c, k_c, v_c = to_chunks(logf), to_chunks(q), to_chunks(key), to_chunks(i)
    cum = jnp.cumsum(logf_c, axis=3)
    causal = jnp.tril(jnp.ones((HG_CHUNK, HG_CHUNK), bool))[:, :, None]
    diff = cum[:, :, :, :, None, :] - cum[:, :, :, None, :, :]
    decay = jnp.where(causal, jnp.exp(jnp.where(causal, diff, 0.0)), 0.0)
    scores = jnp.einsum('bhntk,bhnsk,bhntsk->bhnts', q_c, k_c, decay)
    o_intra = jnp.einsum('bhnts,bhnsv->bhntv', scores, v_c)
    last = cum[:, :, :, -1:, :]
    d_state = jnp.einsum('bhnsk,bhnsv->bhnkv', k_c * jnp.exp(last - cum), v_c)
    chunk_decay = jnp.exp(last[:, :, :, 0, :])

    def step(S, inp):
        dec, dS = inp
        return dec[..., None] * S + dS, S

    S0 = jnp.zeros((B, HG_HEADS, HG_K_DIM, HG_V_DIM), jnp.float32)
    _, S_prev = lax.scan(step, S0, (jnp.moveaxis(chunk_decay, 2, 0), jnp.moveaxis(d_state, 2, 0)))
    S_prev = jnp.moveaxis(S_prev, 0, 2)
    o_inter = jnp.einsum('bhntk,bhnkv->bhntv', q_c * jnp.exp(cum), S_prev)
    return (o_intra + o_inter).transpose(0, 2, 3, 1, 4).reshape(B, T, HG_HEADS, HG_V_DIM)


def compress_blocks(kv, cidx, pe, w1, w2):
    B = kv.shape[0]
    n_cmp = cidx.shape[0]
    blocks = kv[:, cidx] + pe[None, None, :, None, :]
    flat = blocks.transpose(0, 3, 1, 2, 4).reshape(B, NSA_KV_HEADS, n_cmp, CMP_LEN * NSA_DIM)
    return jax.nn.gelu(flat @ w1) @ w2


def nsa_mixer(q, k_cmp, v_cmp, k_slc, v_slc, k_win, v_win, gate_logit, pe_k, pe_v, ck_w1, ck_w2, cv_w1, cv_w2):
    B, T = q.shape[:2]
    G, J, D = NSA_KV_HEADS, NSA_GROUP, NSA_DIM
    scale = D ** -0.5
    q = q.reshape(B, T, G, J, D)
    split_kv = lambda a: a.reshape(B, T, G, D)
    k_cmp, v_cmp, k_slc, v_slc, k_win, v_win = map(split_kv, (k_cmp, v_cmp, k_slc, v_slc, k_win, v_win))
    tpos = jnp.arange(T)

    n_cmp = (T - CMP_LEN) // CMP_STRIDE + 1
    cidx = np.arange(n_cmp)[:, None] * CMP_STRIDE + np.arange(CMP_LEN)[None, :]
    kc = compress_blocks(k_cmp, cidx, pe_k, ck_w1, ck_w2)
    vc = compress_blocks(v_cmp, cidx, pe_v, cv_w1, cv_w2)
    s_c = jnp.einsum('btgjd,bgnd->bgjtn', q, kc) * scale
    cmp_mask = jnp.asarray(cidx[:, -1])[None, :] <= tpos[:, None]
    p_c = masked_softmax(s_c, cmp_mask)
    o_cmp = jnp.einsum('bgjtn,bgnd->btgjd', p_c.astype(vc.dtype), vc)

    n_sel = T // SLC_BLOCK
    c_start = np.arange(n_cmp) * CMP_STRIDE
    s_start = np.arange(n_sel) * SLC_BLOCK
    overlap = ((c_start[:, None] < s_start[None, :] + SLC_BLOCK)
               & (c_start[:, None] + CMP_LEN > s_start[None, :])).astype(np.float32)
    imp = jnp.einsum('bgjtn,ns->bgts', p_c, jnp.asarray(overlap))
    blk = jnp.arange(n_sel)[None, :]
    cur = (tpos // SLC_BLOCK)[:, None]
    forced = (blk == 0) | (blk == cur) | (blk == cur - 1)
    valid = blk * SLC_BLOCK <= tpos[:, None]
    score = jnp.where(valid, imp + jnp.where(forced, FORCE_BONUS, 0.0), -jnp.inf)
    top = min(SLC_TOPK, n_sel)
    _, sel_idx = lax.top_k(score, top)

    kblk = k_slc.reshape(B, n_sel, SLC_BLOCK, G, D).transpose(0, 3, 1, 2, 4)
    vblk = v_slc.reshape(B, n_sel, SLC_BLOCK, G, D).transpose(0, 3, 1, 2, 4)
    nq = T // SLC_Q_BLOCK
    qc = jnp.moveaxis(q.reshape(B, nq, SLC_Q_BLOCK, G, J, D), 1, 0)
    idxc = jnp.moveaxis(sel_idx.reshape(B, G, nq, SLC_Q_BLOCK, top), 2, 0)
    bi = jnp.arange(B)[:, None, None, None]
    gi = jnp.arange(G)[None, :, None, None]

    def sel_block(args):
        qi, ii, c = args
        ksel = kblk[bi, gi, ii]
        vsel = vblk[bi, gi, ii]
        s = jnp.einsum('bqgjd,bgqnld->bgjqnl', qi, ksel) * scale
        s = s.reshape(B, G, J, SLC_Q_BLOCK, top * SLC_BLOCK)
        kpos = ii[..., None] * SLC_BLOCK + jnp.arange(SLC_BLOCK)
        qpos = c * SLC_Q_BLOCK + jnp.arange(SLC_Q_BLOCK)
        mask = (kpos <= qpos[None, None, :, None, None]).reshape(B, G, 1, SLC_Q_BLOCK, top * SLC_BLOCK)
        p = masked_softmax(s, mask)
        return jnp.einsum('bgjqm,bgqmd->bqgjd', p.astype(vsel.dtype),
                          vsel.reshape(B, G, SLC_Q_BLOCK, top * SLC_BLOCK, D))

    o_slc = lax.map(sel_block, (qc, idxc, jnp.arange(nq)))
    o_slc = jnp.moveaxis(o_slc, 0, 1).reshape(B, T, G, J, D)

    nw = T // WIN_Q_BLOCK
    span = WINDOW + WIN_Q_BLOCK
    widx = np.arange(nw)[:, None] * WIN_Q_BLOCK + np.arange(span)[None, :]
    pad = ((0, 0), (WINDOW, 0), (0, 0), (0, 0))
    kwb = jnp.pad(k_win, pad)[:, widx]
    vwb = jnp.pad(v_win, pad)[:, widx]
    qw = q.reshape(B, nw, WIN_Q_BLOCK, G, J, D)
    s_w = jnp.einsum('bnqgjd,bnkgd->bgjnqk', qw, kwb) * scale
    kpos_w = widx - WINDOW
    qpos_w = np.arange(nw)[:, None] * WIN_Q_BLOCK + np.arange(WIN_Q_BLOCK)[None, :]
    dist = qpos_w[:, :, None] - kpos_w[:, None, :]
    p_w = masked_softmax(s_w, jnp.asarray((dist >= 0) & (dist < WINDOW)))
    o_win = jnp.einsum('bgjnqk,bnkgd->bnqgjd', p_w.astype(vwb.dtype), vwb).reshape(B, T, G, J, D)

    g = jax.nn.sigmoid(gate_logit.reshape(B, T, G, J, 3))
    o = g[..., 0:1] * o_cmp + g[..., 1:2] * o_slc + g[..., 2:3] * o_win
    return o.reshape(B, T, D_C)


def setup_inputs(seed: int = 0) -> dict:
    key = jax.random.key(seed)
    ks = jax.random.split(key, 24)
    f32 = jnp.float32

    def nrm(k, shape, scale):
        return jax.random.normal(k, shape, f32) * scale

    def gain(k, shape):
        return 1.0 + 0.01 * jax.random.normal(k, shape, f32)

    cmp_in = CMP_LEN * NSA_DIM
    return {
        "x": nrm(ks[0], (BATCH, SEQ, D_MODEL), 1.0),
        "attn_norm": gain(ks[1], (DEPTH, D_MODEL)),
        "w_in": nrm(ks[2], (DEPTH, D_MODEL, D_IN), D_MODEL ** -0.5),
        "da_lam_q1": nrm(ks[3], (DEPTH, DA_QK_DIM), 0.1),
        "da_lam_k1": nrm(ks[4], (DEPTH, DA_QK_DIM), 0.1),
        "da_lam_q2": nrm(ks[5], (DEPTH, DA_QK_DIM), 0.1),
        "da_lam_k2": nrm(ks[6], (DEPTH, DA_QK_DIM), 0.1),
        "da_norm": gain(ks[7], (DEPTH, DA_HEADS, DA_V_DIM)),
        "hg_gamma": nrm(ks[8], (DEPTH, HG_HEADS * HG_K_DIM), 0.5),
        "hg_norm": gain(ks[9], (DEPTH, HG_HEADS, HG_V_DIM)),
        "nsa_pe_k": nrm(ks[10], (DEPTH, CMP_LEN, NSA_DIM), 0.1),
        "nsa_pe_v": nrm(ks[11], (DEPTH, CMP_LEN, NSA_DIM), 0.1),
        "nsa_ck_w1": nrm(ks[12], (DEPTH, cmp_in, CMP_HIDDEN), cmp_in ** -0.5),
        "nsa_ck_w2": nrm(ks[13], (DEPTH, CMP_HIDDEN, NSA_DIM), CMP_HIDDEN ** -0.5),
        "nsa_cv_w1": nrm(ks[14], (DEPTH, cmp_in, CMP_HIDDEN), cmp_in ** -0.5),
        "nsa_cv_w2": nrm(ks[15], (DEPTH, CMP_HIDDEN, NSA_DIM), CMP_HIDDEN ** -0.5),
        "w_out": nrm(ks[16], (DEPTH, D_MIX, D_MODEL), D_MIX ** -0.5),
        "ffn_norm": gain(ks[17], (DEPTH, D_MODEL)),
        "w_gate": nrm(ks[18], (DEPTH, D_MODEL, D_FF), D_MODEL ** -0.5),
        "w_up": nrm(ks[19], (DEPTH, D_MODEL, D_FF), D_MODEL ** -0.5),
        "w_down": nrm(ks[20], (DEPTH, D_FF, D_MODEL), D_FF ** -0.5),
        "final_norm": gain(ks[21], (D_MODEL,)),
    }


def reference(x, attn_norm, w_in, da_lam_q1, da_lam_k1, da_lam_q2, da_lam_k2, da_norm, hg_gamma, hg_norm,
              nsa_pe_k, nsa_pe_v, nsa_ck_w1, nsa_ck_w2, nsa_cv_w1, nsa_cv_w2, w_out, ffn_norm,
              w_gate, w_up, w_down, final_norm):
    B, T, _ = x.shape
    offsets = np.cumsum(IN_SIZES)[:-1].tolist()
    lbs = jnp.cumsum(jax.nn.softmax(hg_gamma.astype(jnp.float32), axis=0), axis=0)
    lbs = lbs - lbs[0:1]
    for l in range(DEPTH):
        h = rmsnorm(x, attn_norm[l])
        (a_q, a_k, a_v, b_f, b_q, b_i, b_g, c_q, c_kc, c_vc, c_ks, c_vs, c_kw, c_vw, c_g) = \
            jnp.split(h @ w_in[l], offsets, axis=-1)

        lam_init = 0.8 - 0.6 * math.exp(-0.3 * l)
        lam = (jnp.exp(jnp.sum(da_lam_q1[l].astype(jnp.float32) * da_lam_k1[l].astype(jnp.float32)))
               - jnp.exp(jnp.sum(da_lam_q2[l].astype(jnp.float32) * da_lam_k2[l].astype(jnp.float32)))
               + lam_init)
        oa = diff_attention(a_q.reshape(B, T, DA_HEADS, 2, DA_QK_DIM),
                            a_k.reshape(B, T, DA_HEADS, 2, DA_QK_DIM),
                            a_v.reshape(B, T, DA_HEADS, DA_V_DIM), lam)
        ya = (rmsnorm(oa, da_norm[l]) * (1.0 - lam_init)).reshape(B, T, D_A).astype(x.dtype)

        ob = hgrn2_mixer(b_f.reshape(B, T, HG_HEADS, HG_K_DIM), b_q.reshape(B, T, HG_HEADS, HG_K_DIM),
                         b_i.reshape(B, T, HG_HEADS, HG_V_DIM), lbs[l])
        yb = (rmsnorm(ob, hg_norm[l]) * jax.nn.silu(b_g.reshape(B, T, HG_HEADS, HG_V_DIM).astype(jnp.float32)))
        yb = yb.reshape(B, T, D_B).astype(x.dtype)

        yc = nsa_mixer(c_q, c_kc, c_vc, c_ks, c_vs, c_kw, c_vw, c_g, nsa_pe_k[l], nsa_pe_v[l],
                       nsa_ck_w1[l], nsa_ck_w2[l], nsa_cv_w1[l], nsa_cv_w2[l]).astype(x.dtype)

        x = x + jnp.concatenate([ya, yb, yc], axis=-1) @ w_out[l]
        h = rmsnorm(x, ffn_norm[l])
        x = x + (jax.nn.silu(h @ w_gate[l]) * (h @ w_up[l])) @ w_down[l]
    return rmsnorm(x, final_norm)
```

```cpp
#define MK_PER_PHASE 0
#include <hip/hip_runtime.h>
#include <cstdio>
#include <cstdint>
namespace pg8 {
#define PG8_LAS __attribute__((address_space(3)))
typedef unsigned short bf16_t;
typedef short bf16x8 __attribute__((ext_vector_type(8)));
typedef float f32x4 __attribute__((ext_vector_type(4)));
typedef unsigned u32x4 __attribute__((ext_vector_type(4)));
constexpr int BM = 256, BK = 64, HALF = 128, HTB = HALF * BK * 2  , STAGE_BYTES = 8 * HTB, NXCD = 8, WGM = 8;

__host__ __device__ __forceinline__ int lds_byte(int r, int c) { const int st = (r >> 4) * 2 + (c >> 5), rr = r & 15, cc = c & 31, ob = rr * 64 + cc * 2; return st * 1024 + (ob ^ (((ob >> 9) & 1) << 5)); }
__host__ __device__ __forceinline__ void stage_rc(int b, int& R, int& C) { const int st = b / 1024, sb = b % 1024, swz = sb ^ (((sb >> 9) & 1) << 5); R = (st >> 1) * 16 + swz / 64; C = (st & 1) * 32 + (swz % 64) / 2; }
__host__ __device__ __forceinline__ int perm32(int rho) { const int n = rho >> 4, i = rho & 15; return 8 * (i >> 2) + 4 * n + (i & 3); }

struct Unit { int pm, pn; };
struct Gemm { const bf16_t* A; const bf16_t* Bt; int M, N, K; };

struct StaticOrder {
    int nM, nN, nwg, G, c;
    __host__ __device__ __forceinline__ void init(int M, int N, int G_, int c_) { nM = M / BM; nN = N / BM; nwg = nM * nN; G = G_; c = c_; }
    __host__ __device__ __forceinline__ bool next(int i, Unit& u) const {
        const long L = (long)i * G + c; if (L >= nwg) return false;
        int wgid = (int)L; { const int q = nwg / NXCD, r = nwg % NXCD, xcd = wgid % NXCD, off = wgid / NXCD; wgid = (xcd < r ? xcd * (q + 1) : r * (q + 1) + (xcd - r) * q) + off; }
        const int nig = WGM * nN, gid = wgid / nig, fm = gid * WGM, gsz = (nM - fm) < WGM ? (nM - fm) : WGM;
        u.pm = fm + ((wgid % nig) % gsz); u.pn = (wgid % nig) / gsz; return true;
    }
    __device__ __forceinline__ void a_ready(const Unit&) const {}
    __device__ __forceinline__ void done(const Unit&) const {}
};

typedef __bf16 bf16x2n __attribute__((ext_vector_type(2)));
__device__ __forceinline__ unsigned cvt_pk_bf16(float lo, float hi) { bf16x2n v; v[0] = (__bf16)lo; v[1] = (__bf16)hi; return __builtin_bit_cast(unsigned, v); }
__device__ __forceinline__ u32x4 pack8f(const f32x4 a, const f32x4 b) { u32x4 w; w.x = cvt_pk_bf16(a[0], a[1]); w.y = cvt_pk_bf16(a[2], a[3]); w.z = cvt_pk_bf16(b[0], b[1]); w.w = cvt_pk_bf16(b[2], b[3]); return w; }
__device__ __forceinline__ bf16_t f2bf1(float f) { return __builtin_bit_cast(bf16_t, (__bf16)f); }

__device__ __forceinline__ float row_rstd(const float* ssp, int row) { const f32x4 a = *(const f32x4*)(ssp + (size_t)row * 8), b = *(const f32x4*)(ssp + (size_t)row * 8 + 4);
    return rsqrtf((((a[0] + a[1]) + (a[2] + a[3])) + ((b[0] + b[1]) + (b[2] + b[3]))) * (1.f / 2048.f) + 1e-6f); }
struct EpiIn {
    static constexpr bool PERM = true, AFTER_DRAIN = false;
    bf16_t* P; float* LF; float* GT; bf16_t* VT; const float* lb; const float* ss; const PG8_LAS float* rtab; int pm0;
    __device__ __forceinline__ void operator()(const f32x4 (&acc_)[2][2][4][2], const Unit& u, int wr, int wc, int fr, int fq) const {
        const int row0 = u.pm * BM + wr * 64 + fr;
        const int d0 = wc * 32 + 8 * fq;
        f32x4 acc[2][2][4][2];
#pragma unroll
        for (int ai = 0; ai < 2; ++ai)
#pragma unroll
            for (int m = 0; m < 4; ++m) { const float rs = (u.pm == pm0) ? rtab[wr * 64 + fr + ai * HALF + m * 16] : row_rstd(ss, row0 + ai * HALF + m * 16);
#pragma unroll
                for (int bj = 0; bj < 2; ++bj) { acc[ai][bj][m][0] = acc_[ai][bj][m][0] * rs; acc[ai][bj][m][1] = acc_[ai][bj][m][1] * rs; } }
        if (u.pn == 27) {
            if (wc == 0) {
#pragma unroll
                for (int ai = 0; ai < 2; ++ai)
#pragma unroll
                    for (int m = 0; m < 4; ++m) { float* g = GT + (size_t)(row0 + ai * HALF + m * 16) * 32 + 8 * fq; *(f32x4*)g = acc[ai][0][m][0]; *(f32x4*)(g + 4) = acc[ai][0][m][1]; }
            }
            return;
        }
#pragma unroll
        for (int bj = 0; bj < 2; ++bj) {
            const int hd = 2 * u.pn + bj;
            int kind = 0, vh = 0;
            if (hd >= 8 && hd < 12) { kind = 2; vh = hd - 8; } else if (hd == 48 || hd == 49) { kind = 2; vh = hd - 44; } else if (hd == 52 || hd == 53) { kind = 2; vh = hd - 46; } else if (hd >= 12 && hd < 18) kind = 1;
            if (kind == 2) {
#pragma unroll
                for (int ai = 0; ai < 2; ++ai)
#pragma unroll
                    for (int m = 0; m < 4; ++m) { const int row = row0 + ai * HALF + m * 16, b = row >> 11, t = row & 2047;
                        bf16_t* dst = VT + ((size_t)(vh * 4 + b) * 128 + d0) * 2048 + t;
#pragma unroll
                        for (int j = 0; j < 4; ++j) { dst[(size_t)j * 2048] = f2bf1(acc[ai][bj][m][0][j]); dst[(size_t)(4 + j) * 2048] = f2bf1(acc[ai][bj][m][1][j]); } }
            } else if (kind == 1) {
                const f32x4 l0 = *(const f32x4*)(lb + (hd - 12) * 128 + d0), l1 = *(const f32x4*)(lb + (hd - 12) * 128 + d0 + 4);
#pragma unroll
                for (int ai = 0; ai < 2; ++ai)
#pragma unroll
                    for (int m = 0; m < 4; ++m) { const int row = row0 + ai * HALF + m * 16;
                        f32x4 lf0, lf1, k0, k1;
#pragma unroll
                        for (int j = 0; j < 4; ++j) {
                            { const float z = acc[ai][bj][m][0][j], e = __expf(-z), s = __builtin_amdgcn_rcpf(1.f + e), oms = e * s, lbv = l0[j]; lf0[j] = __logf(lbv + (1.f - lbv) * s); k0[j] = (1.f - lbv) * oms; }
                            { const float z = acc[ai][bj][m][1][j], e = __expf(-z), s = __builtin_amdgcn_rcpf(1.f + e), oms = e * s, lbv = l1[j]; lf1[j] = __logf(lbv + (1.f - lbv) * s); k1[j] = (1.f - lbv) * oms; } }
                        float* lp = LF + ((size_t)(hd - 12) * 8192 + row) * 128 + d0; *(f32x4*)lp = lf0; *(f32x4*)(lp + 4) = lf1;
                        *(u32x4*)(P + ((size_t)hd * 8192 + row) * 128 + d0) = pack8f(k0, k1); }
            } else {
                const float qs = (hd < 4) ? 0.125f * 1.4426950408889634f : (hd >= 36 && hd < 42) ? 0.08838834764831845f * 1.4426950408889634f : 1.f;
#pragma unroll
                for (int ai = 0; ai < 2; ++ai)
#pragma unroll
                    for (int m = 0; m < 4; ++m) { const int row = row0 + ai * HALF + m * 16;
                        *(u32x4*)(P + ((size_t)hd * 8192 + row) * 128 + d0) = pack8f(acc[ai][bj][m][0] * qs, acc[ai][bj][m][1] * qs); }
            }
        }
    }
};
struct EpiRes {
    static constexpr bool PERM = false, AFTER_DRAIN = true;
    const bf16_t* baseh; bf16_t* xo; float* ssp;
    __device__ __forceinline__ void fused(f32x4 (&acc)[2][2][4][2], const Unit& u, int wr, int wc, int fr, int fq, PG8_LAS unsigned char* lds, int wid, int lane) const {
        typedef unsigned u32x2_ __attribute__((ext_vector_type(2)));
        PG8_LAS float* T = (PG8_LAS float*)lds;
        const int rl0 = wr * 64 + fr, col0 = u.pn * BM + wc * 32 + 4 * fq;
#pragma unroll
        for (int ai = 0; ai < 2; ++ai)
#pragma unroll
            for (int m = 0; m < 4; ++m) { const int rl = rl0 + ai * HALF + m * 16; const size_t off = (size_t)(u.pm * BM + rl) * 2048 + col0; float q = 0.f;
#pragma unroll
                for (int bj = 0; bj < 2; ++bj)
#pragma unroll
                    for (int n = 0; n < 2; ++n) { const size_t o = off + bj * HALF + n * 16; f32x4 b;
                        { const u32x2_ hb = *(const u32x2_*)(baseh + o); b[0] = __builtin_bit_cast(float, hb.x << 16); b[1] = __builtin_bit_cast(float, hb.x & 0xffff0000u); b[2] = __builtin_bit_cast(float, hb.y << 16); b[3] = __builtin_bit_cast(float, hb.y & 0xffff0000u); }
                        const f32x4 v = b + acc[ai][bj][m][n];
                        u32x2_ w; w.x = cvt_pk_bf16(v[0], v[1]); w.y = cvt_pk_bf16(v[2], v[3]); *(u32x2_*)(xo + o) = w;
                        q += (v[0] * v[0] + v[1] * v[1]) + (v[2] * v[2] + v[3] * v[3]); }
                q += __shfl_xor(q, 16); q += __shfl_xor(q, 32);
                if (fq == 0) T[rl * 4 + wc] = q; }
        asm volatile("s_waitcnt lgkmcnt(0)" ::: "memory"); __builtin_amdgcn_s_barrier(); asm volatile("" ::: "memory");
        const int t = wid * 64 + lane;
        if (t < 256) { const f32x4 v = *(const PG8_LAS f32x4*)(T + t * 4); ssp[(size_t)(u.pm * BM + t) * 8 + u.pn] = (v[0] + v[1]) + (v[2] + v[3]); }
    }
};
struct EpiGU {
    static constexpr bool PERM = true, AFTER_DRAIN = false;
    bf16_t* H; const float* ss; const PG8_LAS float* rtab; int pm0;
    __device__ __forceinline__ void operator()(const f32x4 (&acc)[2][2][4][2], const Unit& u, int wr, int wc, int fr, int fq) const {
        const int row0 = u.pm * BM + wr * 64 + fr, col0 = u.pn * 128 + wc * 32 + 8 * fq;
#pragma unroll
        for (int ai = 0; ai < 2; ++ai)
#pragma unroll
            for (int m = 0; m < 4; ++m) { f32x4 h0, h1; const float rs = (u.pm == pm0) ? rtab[wr * 64 + fr + ai * HALF + m * 16] : row_rstd(ss, row0 + ai * HALF + m * 16);
#pragma unroll
                for (int j = 0; j < 4; ++j) { const float g0 = acc[ai][0][m][0][j] * rs, g1 = acc[ai][0][m][1][j] * rs;
                    h0[j] = g0 * __builtin_amdgcn_rcpf(1.f + __expf(-g0)) * (acc[ai][1][m][0][j] * rs); h1[j] = g1 * __builtin_amdgcn_rcpf(1.f + __expf(-g1)) * (acc[ai][1][m][1][j] * rs); }
                *(u32x4*)(H + (size_t)(row0 + ai * HALF + m * 16) * 5632 + col0) = pack8f(h0, h1); }
    }
};
struct EpiHc {
    static constexpr bool PERM = false, AFTER_DRAIN = false;
    float* HC;
    __device__ __forceinline__ void operator()(const f32x4 (&acc)[2][2][4][2], const Unit& u, int wr, int wc, int fr, int fq) const {
        const int row0 = u.pm * BM + wr * 64 + fr, col0 = (u.pn & 1) * BM + wc * 32 + 4 * fq;
#pragma unroll
        for (int ai = 0; ai < 2; ++ai)
#pragma unroll
            for (int m = 0; m < 4; ++m) { float* rp = HC + (size_t)(row0 + ai * HALF + m * 16) * 512 + col0;
#pragma unroll
                for (int bj = 0; bj < 2; ++bj)
#pragma unroll
                    for (int n = 0; n < 2; ++n) *(f32x4*)(rp + bj * HALF + n * 16) = acc[ai][bj][m][n]; }
    }
};
struct CmpOrder {
    int G, c;
    __device__ __forceinline__ bool next(int i, Unit& u) const { const int L = i * G + c; if (L >= 16) return false; u.pm = L >> 1; u.pn = 2 * (u.pm >> 2) + (L & 1); return true; }
    __device__ __forceinline__ void a_ready(const Unit&) const {}
    __device__ __forceinline__ void done(const Unit&) const {}
};
template <class Epi, class Sched, bool ALIGN_EPI = false, bool SP2 = false>
__device__ __forceinline__ void gemm_phase(PG8_LAS unsigned char* lds, const Gemm g, const Sched& S, const Epi& E) {
    int tid_ = threadIdx.x; asm volatile("" : "+v"(tid_)); const int tid = tid_, wid = __builtin_amdgcn_readfirstlane(tid >> 6), lane = tid & 63, wr = wid >> 2, wc = wid & 3, fr = lane & 15, fq = lane >> 4;
    const int K = g.K, nt = K / BK;
    unsigned voffA[2], voffB[2];
#pragma unroll
    for (int i = 0; i < 2; ++i) { int R, C; stage_rc(tid * 16 + i * 8192, R, C); const int Rb = Epi::PERM ? ((R & ~31) + perm32(R & 31)) : R;
        voffA[i] = (unsigned)(R * K + C) * 2u; voffB[i] = (unsigned)(Rb * K + C) * 2u; }
    const size_t kstep = (size_t)(BK * 2);
    const size_t hstep = (size_t)HALF * K * 2;
    const size_t tstep = 2 * hstep;
    const unsigned ldsw = (unsigned)wid * 1024u;
    const int aoff = lds_byte(wr * 64 + fr, fq * 8), boff = lds_byte(wc * 32 + fr, fq * 8);
#define PG8_SA(b, h) (((b) * 2 + (h)) * HTB)
#define PG8_SB(b, h) ((4 + (b) * 2 + (h)) * HTB)
#define PG8_STAGE(bufoff, gbase, voff) do { _Pragma("unroll") for (int _i = 0; _i < 2; ++_i) \
        __builtin_amdgcn_global_load_lds((const unsigned*)((const char*)(gbase) + (voff)[_i]), (PG8_LAS unsigned*)(lds + (bufoff) + ldsw + _i * 8192), 16, 0, 0); } while (0)
#define PG8_LDA(dst, b, h) do { _Pragma("unroll") for (int m = 0; m < 4; ++m) _Pragma("unroll") for (int k = 0; k < 2; ++k) dst[m][k] = *(const PG8_LAS bf16x8*)(lds + PG8_SA(b, h) + aoff + m * 2048 + k * 1024); } while (0)
#define PG8_LDB(dst, b, h) do { _Pragma("unroll") for (int n = 0; n < 2; ++n) _Pragma("unroll") for (int k = 0; k < 2; ++k) dst[n][k] = *(const PG8_LAS bf16x8*)(lds + PG8_SB(b, h) + boff + n * 2048 + k * 1024); } while (0)
#define PG8_MMA(ai, bj, At, Bt) do { __builtin_amdgcn_s_setprio(1); _Pragma("unroll") for (int m = 0; m < 4; ++m) _Pragma("unroll") for (int n = 0; n < 2; ++n) _Pragma("unroll") for (int k = 0; k < 2; ++k) \
        acc[ai][bj][m][n] = __builtin_amdgcn_mfma_f32_16x16x32_bf16(Bt[n][k], At[m][k], acc[ai][bj][m][n], 0, 0, 0); __builtin_amdgcn_s_setprio(0); } while (0)
#define PG8_WAIT_V(n) asm volatile("s_waitcnt vmcnt(" #n ")" ::: "memory")
#define PG8_WAIT_L(n) asm volatile("s_waitcnt lgkmcnt(" #n ")" ::: "memory")
#define PG8_BAR __builtin_amdgcn_s_barrier()
#define PG8_SCHED __builtin_amdgcn_sched_barrier(0)
    Unit cur, nxt; int ui = 0;
    if (!S.next(0, cur)) return;
    f32x4 acc[2][2][4][2];
#pragma unroll
    for (int a = 0; a < 2; ++a)
#pragma unroll
        for (int b = 0; b < 2; ++b)
#pragma unroll
            for (int m = 0; m < 4; ++m)
#pragma unroll
                for (int n = 0; n < 2; ++n) acc[a][b][m][n] = (f32x4){0.f, 0.f, 0.f, 0.f};
    bf16x8 At[4][2], B0[2][2], B1[2][2];
    const char* cA = (const char*)g.A + (size_t)cur.pm * tstep; const char* cB = (const char*)g.Bt + (size_t)cur.pn * tstep;
    S.a_ready(cur);
    if constexpr (SP2) {
        PG8_STAGE(PG8_SB(0, 0), cB, voffB); PG8_STAGE(PG8_SB(0, 1), cB + hstep, voffB); PG8_STAGE(PG8_SA(0, 0), cA, voffA); PG8_STAGE(PG8_SA(0, 1), cA + hstep, voffA);
        if (wr == 1) PG8_BAR;
        PG8_WAIT_V(2); PG8_BAR;
        PG8_STAGE(PG8_SB(1, 0), cB + kstep, voffB); PG8_STAGE(PG8_SA(1, 0), cA + kstep, voffA); PG8_STAGE(PG8_SB(1, 1), cB + hstep + kstep, voffB);
        PG8_WAIT_V(6); PG8_BAR;
    } else {
        PG8_STAGE(PG8_SB(0, 0), cB, voffB); PG8_STAGE(PG8_SA(0, 0), cA, voffA); PG8_STAGE(PG8_SB(0, 1), cB + hstep, voffB); PG8_STAGE(PG8_SA(0, 1), cA + hstep, voffA);
        if (wr == 1) PG8_BAR;
        PG8_WAIT_V(4); PG8_BAR;
        PG8_STAGE(PG8_SB(1, 0), cB + kstep, voffB); PG8_STAGE(PG8_SA(1, 0), cA + kstep, voffA); PG8_STAGE(PG8_SB(1, 1), cB + hstep + kstep, voffB);
        PG8_WAIT_V(6); PG8_BAR;
    }
    for (;;) {
        const bool has_next = S.next(ui + 1, nxt);
        const char* nA = has_next ? (const char*)g.A + (size_t)nxt.pm * tstep : cA; const char* nB = has_next ? (const char*)g.Bt + (size_t)nxt.pn * tstep : cB;
        for (int t = 0; t < nt; t += 2) {
            const bool last = (t == nt - 2);
            const char* a1 = cA + (size_t)(t + 1) * kstep;
            const char* a2 = last ? nA : cA + (size_t)(t + 2) * kstep; const char* b2 = last ? nB : cB + (size_t)(t + 2) * kstep;
            const char* a3 = a2 + kstep; const char* b3 = b2 + kstep;
            if (last && has_next) S.a_ready(nxt);
            if constexpr (SP2) {
            PG8_LDB(B0, 0, 0); PG8_LDB(B1, 0, 1); PG8_SCHED; PG8_LDA(At, 0, 0); PG8_STAGE(PG8_SA(1, 1), a1 + hstep, voffA);
            PG8_WAIT_V(8); PG8_WAIT_L(0); PG8_BAR; PG8_MMA(0, 0, At, B0); PG8_MMA(0, 1, At, B1); PG8_BAR; PG8_SCHED;
            PG8_LDA(At, 0, 1); PG8_STAGE(PG8_SB(0, 0), b2, voffB); PG8_STAGE(PG8_SB(0, 1), b2 + hstep, voffB); PG8_STAGE(PG8_SA(0, 0), a2, voffA);
            PG8_WAIT_V(8); PG8_WAIT_L(0); PG8_BAR; PG8_MMA(1, 0, At, B0); PG8_MMA(1, 1, At, B1); PG8_BAR; PG8_SCHED;
            PG8_LDB(B0, 1, 0); PG8_LDB(B1, 1, 1); PG8_SCHED; PG8_LDA(At, 1, 0); PG8_STAGE(PG8_SA(0, 1), a2 + hstep, voffA);
            PG8_WAIT_V(8); PG8_WAIT_L(0); PG8_BAR; PG8_MMA(0, 0, At, B0); PG8_MMA(0, 1, At, B1); PG8_BAR; PG8_SCHED;
            PG8_LDA(At, 1, 1); PG8_STAGE(PG8_SB(1, 0), b3, voffB); PG8_STAGE(PG8_SB(1, 1), b3 + hstep, voffB); PG8_STAGE(PG8_SA(1, 0), a3, voffA);
            PG8_WAIT_V(8); PG8_WAIT_L(0); PG8_BAR; PG8_MMA(1, 0, At, B0); PG8_MMA(1, 1, At, B1); PG8_BAR; PG8_SCHED;
            } else {
            PG8_LDB(B0, 0, 0); PG8_SCHED; PG8_LDA(At, 0, 0); PG8_STAGE(PG8_SA(1, 1), a1 + hstep, voffA);
            PG8_WAIT_L(8); PG8_BAR; PG8_WAIT_L(0); PG8_MMA(0, 0, At, B0); PG8_BAR; PG8_SCHED;
            PG8_LDB(B1, 0, 1); PG8_STAGE(PG8_SB(0, 0), b2, voffB);
            PG8_BAR; PG8_WAIT_L(0); PG8_MMA(0, 1, At, B1); PG8_BAR;
            PG8_LDA(At, 0, 1); PG8_STAGE(PG8_SA(0, 0), a2, voffA);
            PG8_BAR; PG8_WAIT_L(0); PG8_MMA(1, 0, At, B0); PG8_BAR; PG8_SCHED;
            PG8_STAGE(PG8_SB(0, 1), b2 + hstep, voffB);
            PG8_WAIT_V(6); PG8_BAR; PG8_MMA(1, 1, At, B1); PG8_BAR;
            PG8_LDB(B0, 1, 0); PG8_SCHED; PG8_LDA(At, 1, 0); PG8_STAGE(PG8_SA(0, 1), a2 + hstep, voffA);
            PG8_WAIT_L(8); PG8_BAR; PG8_WAIT_L(0); PG8_MMA(0, 0, At, B0); PG8_BAR; PG8_SCHED;
            PG8_LDB(B1, 1, 1); PG8_STAGE(PG8_SB(1, 0), b3, voffB);
            PG8_BAR; PG8_WAIT_L(0); PG8_MMA(0, 1, At, B1); PG8_BAR;
            PG8_LDA(At, 1, 1); PG8_STAGE(PG8_SA(1, 0), a3, voffA);
            PG8_BAR; PG8_WAIT_L(0); PG8_MMA(1, 0, At, B0); PG8_BAR; PG8_SCHED;
            PG8_STAGE(PG8_SB(1, 1), b3 + hstep, voffB);
            PG8_WAIT_V(6); PG8_BAR; PG8_MMA(1, 1, At, B1); PG8_BAR;
            }
        }
        if constexpr (ALIGN_EPI) { if (wr == 0) PG8_BAR; }
        if constexpr (!Epi::AFTER_DRAIN) { E(acc, cur, wr, wc, fr, fq); S.done(cur); }
        if (!has_next) break;
#pragma unroll
        for (int a = 0; a < 2; ++a)
#pragma unroll
            for (int b = 0; b < 2; ++b)
#pragma unroll
                for (int m = 0; m < 4; ++m)
#pragma unroll
                    for (int n = 0; n < 2; ++n) acc[a][b][m][n] = (f32x4){0.f, 0.f, 0.f, 0.f};
        cur = nxt; cA = nA; cB = nB; ++ui;
        if constexpr (ALIGN_EPI) { if (wr == 1) PG8_BAR; }
    }
    PG8_WAIT_V(0);
    if constexpr (!ALIGN_EPI) { if (wr == 0) PG8_BAR; }
    PG8_BAR;
    if constexpr (Epi::AFTER_DRAIN) { E.fused(acc, cur, wr, wc, fr, fq, lds, wid, lane); S.done(cur); }
#undef PG8_SA
#undef PG8_SB
#undef PG8_STAGE
#undef PG8_LDA
#undef PG8_LDB
#undef PG8_MMA
#undef PG8_WAIT_V
#undef PG8_WAIT_L
#undef PG8_BAR
#undef PG8_SCHED
}
}

#define LAS __attribute__((address_space(3)))
typedef unsigned short bf16;
typedef short bf16x8 __attribute__((ext_vector_type(8)));
typedef float f32x4 __attribute__((ext_vector_type(4)));
typedef unsigned u32x4 __attribute__((ext_vector_type(4)));
typedef unsigned u32x2 __attribute__((ext_vector_type(2)));

constexpr int NB = 4, NT = 2048, NM = NB * NT, ND = 2048, DIN = 6930, NPAD = 7168, DFF = 5632, NL = 4;
constexpr int HD_AQ = 0, HD_AK = 4, HD_BF = 12, HD_BQ = 18, HD_BI = 24, HD_BG = 30, HD_CQ = 36, HD_CKC = 42, HD_CKS = 46, HD_CKW = 50;
constexpr size_t HDSZ = (size_t)NM * 128;
constexpr float EPS = 1e-6f;
constexpr float LOG2E = 1.4426950408889634f;
#ifndef PROBE_CMP
#define PROBE_CMP 1.f
#endif
#ifndef PROBE_SEL
#define PROBE_SEL 1.f
#endif
#ifndef PROBE_WIN
#define PROBE_WIN 1.f
#endif

constexpr size_t MiB = 1u << 20;
constexpr size_t WS_CTL = 0, CTL_ZERO_BYTES = 1 * MiB;
constexpr size_t WS_SMALL = 1 * MiB;
constexpr size_t WS_W = 2 * MiB;
constexpr size_t WL_IN = 0, WL_OUT = 28 * MiB, WL_GU = 36 * MiB, WL_DN = 80 * MiB, WL_C1 = 102 * MiB, WL_W2 = 106 * MiB, WL_SZ = 107 * MiB;
constexpr size_t WS_XA = WS_W + NL * WL_SZ;
constexpr size_t WS_HN = WS_XA + 32 * MiB;
constexpr size_t WS_P = WS_HN + 32 * MiB;
constexpr size_t WS_LF = WS_P + 108 * MiB;
constexpr size_t WS_HF = WS_P;
constexpr size_t WS_GT = WS_LF + 24 * MiB;
constexpr size_t WS_VT = WS_GT + 1 * MiB;
constexpr size_t WS_Y = WS_VT + 16 * MiB;
constexpr size_t WS_YW = WS_Y + 32 * MiB;
constexpr size_t WS_YCM = WS_YW + 24 * MiB;
constexpr size_t WS_HC = WS_YCM + 24 * MiB;
constexpr size_t WS_KC = WS_HC + 4 * MiB;
constexpr size_t WS_SELM = WS_KC + 1 * MiB;
constexpr size_t WS_DS = WS_SELM + 1 * MiB;
constexpr size_t WS_DEC = WS_DS + 48 * MiB;
constexpr size_t WS_SP = WS_DEC + 1 * MiB;
constexpr size_t WS_SSP = WS_SP + 24 * MiB;
constexpr size_t WS_END = WS_SSP + 3 * MiB;
static_assert(WS_HF + 88 * MiB <= WS_GT, "HF overlay");
constexpr int CW_BAR = 4096;
constexpr int CW_Q = 16384;

constexpr int LDS_BYTES = 147456;
constexpr int MISC_OFF = 147456 - 256;

__device__ __forceinline__ unsigned f2bf(float f) { return (unsigned)__builtin_bit_cast(unsigned short, (__bf16)f); }
__device__ __forceinline__ unsigned pk2(float lo, float hi) { return pg8::cvt_pk_bf16(lo, hi); }
__device__ __forceinline__ float bf2f(unsigned short b) { return __builtin_bit_cast(float, (unsigned)b << 16); }
__device__ __forceinline__ float wave_sum(float v) {
#pragma unroll
    for (int o = 1; o < 64; o <<= 1) v += __shfl_xor(v, o);
    return v;
}
#define LDS_WAIT() asm volatile("s_waitcnt lgkmcnt(0)" ::: "memory")
#define VM_WAIT() asm volatile("s_waitcnt vmcnt(0)" ::: "memory")
__device__ __forceinline__ unsigned cvt_pk_nop(float lo, float hi) { return pg8::cvt_pk_bf16(lo, hi); }
__device__ __forceinline__ f32x4 mfma16(bf16x8 a, bf16x8 b, f32x4 c) { return __builtin_amdgcn_mfma_f32_16x16x32_bf16(a, b, c, 0, 0, 0); }

#define XB_TMO      128
#define XB_XCNT(j)  (256  + 64 * (j))
#define XB_XSUB(j)  (1280 + 64 * (j))
#define XB_XGEN(j)  (2304 + 64 * (j))
#define XB_TOP      3328
#define XB_TOPGEN   3392
#define XCD_BAR_WORDS 3456
#define XB_SPIN_CAP (1u << 22)
__device__ __forceinline__ unsigned xb_ld(unsigned* p)              { return __hip_atomic_load(p, __ATOMIC_RELAXED, __HIP_MEMORY_SCOPE_AGENT); }
__device__ __forceinline__ unsigned xb_add(unsigned* p, unsigned v) { return __hip_atomic_fetch_add(p, v, __ATOMIC_RELAXED, __HIP_MEMORY_SCOPE_AGENT); }
__device__ __forceinline__ unsigned xb_xcc_id() { return (unsigned)__builtin_amdgcn_s_getreg((3 << 11) | 20) & 0xFu; }
#define XB_SPIN(cond, bar) do { unsigned _sp = 0; while (cond) { __builtin_amdgcn_s_sleep(1); \
    if ((++_sp & 255u) == 0u) { if (xb_ld(&(bar)[XB_TMO])) break; if (_sp > XB_SPIN_CAP) { atomicAdd(&(bar)[XB_TMO], 1u); break; } } } } while (0)
struct XcdBarrier { unsigned* bar; unsigned x; volatile LAS unsigned* st; };
__device__ __forceinline__ XcdBarrier xcd_barrier_post(unsigned* bar, volatile LAS unsigned* st) {
    XcdBarrier b; b.bar = bar; b.x = xb_xcc_id(); b.st = st;
    if (threadIdx.x == 0) (void)xb_add(&bar[XB_XCNT(b.x)], 1u);
    return b;
}
__device__ __forceinline__ void xcd_barrier_complete(unsigned* bar, unsigned x, unsigned& nloc, unsigned& nx) {
    const unsigned G = gridDim.x * gridDim.y * gridDim.z;
    unsigned sum, cnt, mine, sp = 0u;
    for (;;) {
        sum = 0u; cnt = 0u; mine = 0u;
#pragma unroll
        for (unsigned j = 0; j < 16; ++j) { const unsigned c = xb_ld(&bar[XB_XCNT(j)]); sum += c; cnt += (c > 0u) ? 1u : 0u; mine = (j == x) ? c : mine; }
        if (sum == G) break;
        __builtin_amdgcn_s_sleep(1);
        if ((++sp & 255u) == 0u) { if (xb_ld(&bar[XB_TMO])) break; if (sp > XB_SPIN_CAP) { atomicAdd(&bar[XB_TMO], 1u); break; } }
    }
    nloc = mine > 0u ? mine : 1u; nx = cnt > 0u ? cnt : 1u;
}
__device__ __forceinline__ void xcd_barrier(const XcdBarrier& b) {
    asm volatile("s_waitcnt vmcnt(0)" ::: "memory");
    __syncthreads();
    if (threadIdx.x == 0) {
        unsigned* bar = b.bar;
        __builtin_amdgcn_s_waitcnt(0);
        unsigned nloc = b.st[0], nx = b.st[1];
        if (nloc == 0u) { xcd_barrier_complete(bar, b.x, nloc, nx); b.st[0] = nloc; b.st[1] = nx; }
        const unsigned old = xb_add(&bar[XB_XSUB(b.x)], 1u);
        const unsigned gen = old / nloc;
        if (old + 1u == (gen + 1u) * nloc) {
            __builtin_amdgcn_fence(__ATOMIC_RELEASE, "agent");
            asm volatile("s_waitcnt vmcnt(0)" ::: "memory");
            const unsigned og = xb_add(&bar[XB_TOP], 1u);
            const unsigned tg = og / nx;
            if (og + 1u == (tg + 1u) * nx) xb_add(&bar[XB_TOPGEN], 1u);
            else XB_SPIN(xb_ld(&bar[XB_TOPGEN]) == tg, bar);
            __builtin_amdgcn_fence(__ATOMIC_ACQUIRE, "agent");
            xb_add(&bar[XB_XGEN(b.x)], 1u);
            asm volatile("s_waitcnt vmcnt(0)" ::: "memory");
        } else {
            XB_SPIN(xb_ld(&bar[XB_XGEN(b.x)]) == gen, bar);
            __builtin_amdgcn_fence(__ATOMIC_ACQUIRE, "agent");
            asm volatile("s_waitcnt vmcnt(0)" ::: "memory");
        }
    }
    __syncthreads();
}

struct Params {
    const float* x; const float* attn_norm; const float* w_in; const float* lq1; const float* lk1; const float* lq2; const float* lk2; const float* da_norm;
    const float* hg_gamma; const float* hg_norm; const float* pe_k; const float* pe_v; const float* ck_w1; const float* ck_w2; const float* cv_w1; const float* cv_w2;
    const float* w_out; const float* ffn_norm; const float* w_gate; const float* w_up; const float* w_down; const float* final_norm;
    float* out; unsigned char* ws; int ph_lo, ph_hi;
};
struct Ctx { LAS unsigned char* lds; int tid, lane, wave, bid, G; unsigned* ctl; };

__device__ __forceinline__ int q_next(const Ctx& C, unsigned* qbase  , int N, int& sub  ) {
    volatile LAS int* slot = (volatile LAS int*)(C.lds + MISC_OFF + 16);
    __syncthreads();
    if (C.tid == 0) {
        int x = sub < 0 ? (C.bid & 7) : sub, it = N;
        for (int tries = 0; tries < 8; ++tries) {
            const int k = (int)__hip_atomic_fetch_add(qbase + 64 * x, 1u, __ATOMIC_RELAXED, __HIP_MEMORY_SCOPE_AGENT);
            if (8 * k + x < N) { it = 8 * k + x; break; }
            if (C.G >= 8 && (C.G & 7) == 0) break;
            x = (x + 1) & 7; }
        slot[0] = it; slot[1] = x; }
    __syncthreads();
    sub = slot[1];
    return slot[0];
}

struct CvDesc { const float* W; bf16* WT; const float* gain; int ldw, nvalid, k0, n0, ldt, orow0; };
constexpr int IT_IN = 16 * 112, IT_OUT = 16 * 32, IT_G = 16 * 88, IT_DN = 44 * 32, IT_C1 = 16 * 4, IT_W2 = 2 * 2;
constexpr int IT_LAYER = IT_IN + IT_OUT + 2 * IT_G + IT_DN + 4 * IT_C1 + 2 * IT_W2;
constexpr int CV_TILE = 64 * 65;
static_assert(4096 + 8 * CV_TILE * 4 <= MISC_OFF, "conversion tiles");
__device__ __forceinline__ void cv_decode(const Params& p, int it, CvDesc& d) {
    const int l = it / IT_LAYER; int r = it - l * IT_LAYER;
    unsigned char* wl = p.ws + WS_W + (size_t)l * WL_SZ;
    d.gain = nullptr;
    if (r < IT_IN) { const int kb = r / 112, nb = r % 112; d.W = p.w_in + (size_t)l * ND * DIN; d.ldw = DIN; d.nvalid = DIN; d.k0 = kb * 128; d.n0 = nb * 64; d.WT = (bf16*)(wl + WL_IN); d.ldt = ND; d.orow0 = nb * 64; d.gain = p.attn_norm + (size_t)l * ND; return; } r -= IT_IN;
    if (r < IT_OUT) { const int kb = r / 32, nb = r % 32; d.W = p.w_out + (size_t)l * ND * ND; d.ldw = ND; d.nvalid = ND; d.k0 = kb * 128; d.n0 = nb * 64; d.WT = (bf16*)(wl + WL_OUT); d.ldt = ND; d.orow0 = nb * 64; return; } r -= IT_OUT;
    if (r < 2 * IT_G) { const int up = r >= IT_G; if (up) r -= IT_G; const int kb = r / 88, nb = r % 88, n0 = nb * 64; d.W = (up ? p.w_up : p.w_gate) + (size_t)l * ND * DFF; d.ldw = DFF; d.nvalid = DFF; d.k0 = kb * 128; d.n0 = n0;
        d.WT = (bf16*)(wl + WL_GU); d.ldt = ND; d.orow0 = 256 * (n0 >> 7) + 128 * up + (n0 & 127); d.gain = p.ffn_norm + (size_t)l * ND; return; } r -= 2 * IT_G;
    if (r < IT_DN) { const int kb = r / 32, nb = r % 32; d.W = p.w_down + (size_t)l * DFF * ND; d.ldw = ND; d.nvalid = ND; d.k0 = kb * 128; d.n0 = nb * 64; d.WT = (bf16*)(wl + WL_DN); d.ldt = DFF; d.orow0 = nb * 64; return; } r -= IT_DN;
    if (r < 4 * IT_C1) { const int q = r / IT_C1, rr = r % IT_C1, kb = rr / 4, nb = rr % 4, kv = q >> 1, half = q & 1;
        d.W = (kv ? p.cv_w1 : p.ck_w1) + (size_t)l * 4096 * 256 + (size_t)half * 2048 * 256; d.ldw = 256; d.nvalid = 256; d.k0 = kb * 128; d.n0 = nb * 64;
        d.WT = (bf16*)(wl + WL_C1) + (size_t)kv * 512 * 2048; d.ldt = 2048; d.orow0 = half * 256 + nb * 64; return; } r -= 4 * IT_C1;
    { const int kv = r / IT_W2, rr = r % IT_W2, kb = rr / 2, nb = rr % 2;
        d.W = (kv ? p.cv_w2 : p.ck_w2) + (size_t)l * 256 * 128; d.ldw = 128; d.nvalid = 128; d.k0 = kb * 128; d.n0 = nb * 64; d.WT = (bf16*)(wl + WL_W2) + (size_t)kv * 128 * 256; d.ldt = 256; d.orow0 = nb * 64; }
}
__device__ __forceinline__ void cv_load(const CvDesc& d, int hb, int lane, float (&t)[32]) {
    const int n = d.n0 + lane;
    const float* wp = d.W + (size_t)(d.k0 + hb) * d.ldw + (n < d.nvalid ? n : 0);
#pragma unroll
    for (int i = 0; i < 32; ++i) t[i] = wp[(size_t)i * d.ldw];
}
__device__ __forceinline__ void cv_put(const CvDesc& d, int hb, int lane, LAS unsigned* scr, const float (&t)[32]) {
    const bool ok = d.n0 + lane < d.nvalid;
#pragma unroll
    for (int i = 0; i < 16; ++i) { float v0 = ok ? t[2 * i] : 0.f, v1 = ok ? t[2 * i + 1] : 0.f; if (d.gain) { v0 *= d.gain[d.k0 + hb + 2 * i]; v1 *= d.gain[d.k0 + hb + 2 * i + 1]; }
        scr[((hb >> 1) + i) * 65 + lane] = pk2(v0, v1); }
}
__device__ __forceinline__ void cv_out(const CvDesc& d, int lane, const LAS unsigned* scr) {
    LDS_WAIT(); asm volatile("" ::: "memory");
    const int c = lane & 15;
#pragma unroll
    for (int j = 0; j < 16; ++j) { const int nn = (lane >> 4) + 4 * j; const LAS unsigned* s = scr + (4 * c) * 65 + nn;
        u32x4 o; o.x = s[0]; o.y = s[65]; o.z = s[130]; o.w = s[195];
        *(u32x4*)(d.WT + (size_t)(d.orow0 + nn) * d.ldt + d.k0 + 8 * c) = o; }
    LDS_WAIT(); asm volatile("" ::: "memory");
}
struct CwDesc { const float* W; bf16* WT; const float* gain; int ldw, nvalid, k0, n0, ldt, orow0, kind, up, nout; };
constexpr int CWI_IN = 8 * 28, CWI_OUT = 8 * 8, CWI_G = 8 * 22, CWI_DN = 22 * 8, CWI_C1 = 8, CWI_W2 = 1;
constexpr int CWI_LAYER = CWI_IN + CWI_OUT + 2 * CWI_G + CWI_DN + 4 * CWI_C1 + 2 * CWI_W2;
constexpr int CW_TILE_OFF = 4096;
static_assert(CW_TILE_OFF + (128 * 257 + 8) * 4 <= MISC_OFF, "cooperative conversion tile");
__device__ __forceinline__ void cw_decode(const Params& p, int it, CwDesc& d) {
    const int l = it / CWI_LAYER; int r = it - l * CWI_LAYER;
    unsigned char* wl = p.ws + WS_W + (size_t)l * WL_SZ;
    d.gain = nullptr; d.kind = 0; d.up = 0; d.nout = 256;
    if (r < CWI_IN) { const int kb = r / 28, nb = r % 28; d.W = p.w_in + (size_t)l * ND * DIN; d.ldw = DIN; d.nvalid = DIN; d.k0 = kb * 256; d.n0 = nb * 256; d.WT = (bf16*)(wl + WL_IN); d.ldt = ND; d.orow0 = nb * 256; d.gain = p.attn_norm + (size_t)l * ND; return; } r -= CWI_IN;
    if (r < CWI_OUT) { const int kb = r / 8, nb = r % 8; d.W = p.w_out + (size_t)l * ND * ND; d.ldw = ND; d.nvalid = ND; d.k0 = kb * 256; d.n0 = nb * 256; d.WT = (bf16*)(wl + WL_OUT); d.ldt = ND; d.orow0 = nb * 256; return; } r -= CWI_OUT;
    if (r < 2 * CWI_G) { const int up = r >= CWI_G; if (up) r -= CWI_G; const int kb = r / 22, nb = r % 22; d.W = (up ? p.w_up : p.w_gate) + (size_t)l * ND * DFF; d.ldw = DFF; d.nvalid = DFF; d.k0 = kb * 256; d.n0 = nb * 256;
        d.WT = (bf16*)(wl + WL_GU); d.ldt = ND; d.orow0 = 0; d.kind = 1; d.up = up; d.gain = p.ffn_norm + (size_t)l * ND; return; } r -= 2 * CWI_G;
    if (r < CWI_DN) { const int kb = r / 8, nb = r % 8; d.W = p.w_down + (size_t)l * DFF * ND; d.ldw = ND; d.nvalid = ND; d.k0 = kb * 256; d.n0 = nb * 256; d.WT = (bf16*)(wl + WL_DN); d.ldt = DFF; d.orow0 = nb * 256; return; } r -= CWI_DN;
    if (r < 4 * CWI_C1) { const int q = r / CWI_C1, kb = r % CWI_C1, kv = q >> 1, half = q & 1;
        d.W = (kv ? p.cv_w1 : p.ck_w1) + (size_t)l * 4096 * 256 + (size_t)half * 2048 * 256; d.ldw = 256; d.nvalid = 256; d.k0 = kb * 256; d.n0 = 0;
        d.WT = (bf16*)(wl + WL_C1) + (size_t)kv * 512 * 2048; d.ldt = 2048; d.orow0 = half * 256; return; } r -= 4 * CWI_C1;
    { const int kv = r;
        d.W = (kv ? p.cv_w2 : p.ck_w2) + (size_t)l * 256 * 128; d.ldw = 128; d.nvalid = 128; d.k0 = 0; d.n0 = 0; d.WT = (bf16*)(wl + WL_W2) + (size_t)kv * 128 * 256; d.ldt = 256; d.orow0 = 0; d.nout = 128; }
}
typedef float f32x2 __attribute__((ext_vector_type(2)));
__device__ __forceinline__ void cw_load(const CwDesc& d, int wave, int hb  , int lane, f32x2 (&t)[16][2]) {
    const int n = d.n0 + 4 * lane; const bool ok0 = n < d.nvalid, ok1 = n + 2 < d.nvalid;
    const float* wp = d.W + (size_t)(d.k0 + 32 * wave + hb) * d.ldw + (ok0 ? n : 0);
    const int o1 = ok1 ? 2 : 0;
#pragma unroll
    for (int i = 0; i < 16; ++i) { t[i][0] = *(const f32x2*)(wp + (size_t)i * d.ldw); t[i][1] = *(const f32x2*)(wp + (size_t)i * d.ldw + o1); }
}
__device__ __forceinline__ void cw_put(const CwDesc& d, int wave, int hb, int lane, LAS unsigned* tile, const f32x2 (&t)[16][2]) {
    const int n = d.n0 + 4 * lane; const bool ok0 = n < d.nvalid, ok1 = n + 2 < d.nvalid;
#pragma unroll
    for (int i = 0; i < 8; ++i) { const int pr = 16 * wave + (hb >> 1) + i; float g0 = 1.f, g1 = 1.f; if (d.gain) { g0 = d.gain[d.k0 + 2 * pr]; g1 = d.gain[d.k0 + 2 * pr + 1]; }
        LAS unsigned* w = tile + pr * 257 + (pr >> 5) + 4 * lane;
        w[0] = ok0 ? pk2(t[2 * i][0][0] * g0, t[2 * i + 1][0][0] * g1) : 0u; w[1] = ok0 ? pk2(t[2 * i][0][1] * g0, t[2 * i + 1][0][1] * g1) : 0u;
        w[2] = ok1 ? pk2(t[2 * i][1][0] * g0, t[2 * i + 1][1][0] * g1) : 0u; w[3] = ok1 ? pk2(t[2 * i][1][1] * g0, t[2 * i + 1][1][1] * g1) : 0u; }
}
__device__ __forceinline__ void cw_out(const CwDesc& d, int wave, int lane, const LAS unsigned* tile) {
    const int c = lane & 31;
#pragma unroll
    for (int j = 0; j < 16; ++j) { const int nn = 32 * wave + (lane >> 5) + 2 * j; const LAS unsigned* s = tile + (4 * c) * 257 + (c >> 3) + nn;
        u32x4 o; o.x = s[0]; o.y = s[257]; o.z = s[514]; o.w = s[771];
        const int ng = d.n0 + nn, orow = d.kind ? 256 * (ng >> 7) + 128 * d.up + (ng & 127) : d.orow0 + nn;
        if (nn < d.nout) *(u32x4*)(d.WT + (size_t)orow * d.ldt + d.k0 + 8 * c) = o; }
}
__device__ __forceinline__ void cw_run(const Ctx& C, const Params& p) {
    LAS unsigned* tile = (LAS unsigned*)(C.lds + CW_TILE_OFF);
    if (C.bid < NL * CWI_LAYER) {
        CwDesc d; f32x2 ta[16][2], tb[16][2];
        cw_decode(p, C.bid, d); cw_load(d, C.wave, 0, C.lane, ta);
#pragma unroll 1
        for (int it = C.bid; it < NL * CWI_LAYER; it += C.G) {
            cw_load(d, C.wave, 16, C.lane, tb);
            cw_put(d, C.wave, 0, C.lane, tile, ta);
            CwDesc dn = d; const bool more = it + C.G < NL * CWI_LAYER;
            if (more) { cw_decode(p, it + C.G, dn); cw_load(dn, C.wave, 0, C.lane, ta); }
            cw_put(d, C.wave, 16, C.lane, tile, tb);
            __syncthreads();
            cw_out(d, C.wave, C.lane, tile);
            __syncthreads();
            d = dn; }
    }
}
__device__ __forceinline__ void p0_prologue(const Ctx& C, const Params& p) {
    unsigned char* ws = p.ws;
    float* small = (float*)(ws + WS_SMALL);
    {
        const int q8 = C.bid >> 5, sl = C.bid & 31, l = q8 >> 1, kv = q8 & 1, c = C.tid & 255, half = C.tid >> 8;
        if (q8 < 8) {
        const float* pe = (kv ? p.pe_v : p.pe_k) + (size_t)l * 4096; const float* w1 = (kv ? p.cv_w1 : p.ck_w1) + (size_t)l * 4096 * 256;
        float a = 0.f;
#pragma unroll 16
        for (int r = sl * 128 + half * 64; r < sl * 128 + half * 64 + 64; ++r) a += pe[r] * w1[(size_t)r * 256 + c];
        LAS float* red = (LAS float*)C.lds;
        if (half == 1) red[c] = a;
        __syncthreads();
        if (half == 0) small[8192 + (q8 * 32 + sl) * 256 + c] = a + red[c];
        __syncthreads(); }
    }
    if (C.bid == 8) {

        for (int c = C.tid; c < 768; c += 512) {
            float g[NL], mx = -1e30f; for (int l = 0; l < NL; ++l) { g[l] = p.hg_gamma[l * 768 + c]; mx = fmaxf(mx, g[l]); }
            float s = 0.f; for (int l = 0; l < NL; ++l) { g[l] = __expf(g[l] - mx); s += g[l]; }
            float cum = 0.f, first = g[0] / s;
            for (int l = 0; l < NL; ++l) { cum += g[l] / s; small[4 + l * 768 + c] = cum - first; }
        }
        if (C.tid < NL) { const int l = C.tid; float s1 = 0.f, s2 = 0.f;
            for (int i = 0; i < 64; ++i) { s1 += p.lq1[l * 64 + i] * p.lk1[l * 64 + i]; s2 += p.lq2[l * 64 + i] * p.lk2[l * 64 + i]; }
            small[l] = expf(s1) - expf(s2) + (0.8f - 0.6f * expf(-0.3f * (float)l)); }
    }
    { const int gw_ = C.bid * 8 + C.wave, NGW_ = C.G * 8; bf16* HN = (bf16*)(ws + WS_HN); float* SS = (float*)(ws + WS_SSP);
      for (int row = gw_; row < NM; row += NGW_) { const float* xr = p.x + (size_t)row * ND + C.lane * 4; float q = 0.f;
#pragma unroll
          for (int j = 0; j < 8; ++j) { const f32x4 v = *(const f32x4*)(xr + j * 256); q += (v[0] * v[0] + v[1] * v[1]) + (v[2] * v[2] + v[3] * v[3]);
              u32x2 w; w.x = pk2(v[0], v[1]); w.y = pk2(v[2], v[3]); *(u32x2*)(HN + (size_t)row * ND + j * 256 + C.lane * 4) = w; }
          q = wave_sum(q); if (C.lane < 8) SS[(size_t)row * 8 + C.lane] = C.lane == 0 ? q : 0.f; } }
    __syncthreads();
    cw_run(C, p);
}

__device__ __forceinline__ void norm_rows(const Ctx& C, const float* src, const float* gain, bf16* dst_bf, float* dst_f) {
    const int gw = C.bid * 8 + C.wave, NGW = C.G * 8;
    for (int row = gw; row < NM; row += NGW) {
        const float* xr = src + (size_t)row * ND + C.lane * 4;
        f32x4 v[8]; float ss = 0.f;
#pragma unroll
        for (int j = 0; j < 8; ++j) { v[j] = *(const f32x4*)(xr + j * 256); ss += (v[j][0] * v[j][0] + v[j][1] * v[j][1]) + (v[j][2] * v[j][2] + v[j][3] * v[j][3]); }
        const float r = rsqrtf(wave_sum(ss) * (1.f / ND) + EPS);
#pragma unroll
        for (int j = 0; j < 8; ++j) { const f32x4 g = *(const f32x4*)(gain + j * 256 + C.lane * 4); const f32x4 y = v[j] * r * g;
            if (dst_bf) { u32x2 w; w.x = pk2(y[0], y[1]); w.y = pk2(y[2], y[3]); *(u32x2*)(dst_bf + (size_t)row * ND + j * 256 + C.lane * 4) = w; }
            else *(f32x4*)(dst_f + (size_t)row * ND + j * 256 + C.lane * 4) = y; }
    }
}

__device__ __forceinline__ void final_norm_rows(const Ctx& C, const bf16* src, const float* gain, float* dst) {
    const int gw = C.bid * 8 + C.wave, NGW = C.G * 8;
    for (int row = gw; row < NM; row += NGW) {
        const bf16* xr = src + (size_t)row * ND + C.lane * 8;
        f32x4 v[8]; float ss = 0.f;
#pragma unroll
        for (int j = 0; j < 4; ++j) { const u32x4 h = *(const u32x4*)(xr + j * 512);
            v[2 * j] = (f32x4){__builtin_bit_cast(float, h.x << 16), __builtin_bit_cast(float, h.x & 0xffff0000u), __builtin_bit_cast(float, h.y << 16), __builtin_bit_cast(float, h.y & 0xffff0000u)};
            v[2 * j + 1] = (f32x4){__builtin_bit_cast(float, h.z << 16), __builtin_bit_cast(float, h.z & 0xffff0000u), __builtin_bit_cast(float, h.w << 16), __builtin_bit_cast(float, h.w & 0xffff0000u)}; }
#pragma unroll
        for (int j = 0; j < 8; ++j) ss += (v[j][0] * v[j][0] + v[j][1] * v[j][1]) + (v[j][2] * v[j][2] + v[j][3] * v[j][3]);
        const float r = rsqrtf(wave_sum(ss) * (1.f / ND) + EPS);
#pragma unroll
        for (int j = 0; j < 4; ++j) { const float* gp = gain + j * 512 + C.lane * 8; float* dp = dst + (size_t)row * ND + j * 512 + C.lane * 8;
            *(f32x4*)dp = v[2 * j] * r * *(const f32x4*)gp; *(f32x4*)(dp + 4) = v[2 * j + 1] * r * *(const f32x4*)(gp + 4); }
    }
}

constexpr int AT_K_BYTES = 64 * 256, AT_V_BYTES = 128 * 128;
constexpr int AT_K_OFF = 0, AT_V_OFF = 2 * AT_K_BYTES, AT_END = AT_V_OFF + 2 * AT_V_BYTES;
constexpr int AT_X_BYTES = 128 * 32 * 4 + 256;
static_assert(AT_END <= MISC_OFF && 6 * AT_X_BYTES <= MISC_OFF, "attention LDS");
enum { MODE_DIFF = 0, MODE_WIN = 1, MODE_SEL = 2 };

struct AttnOut { f32x4 o[2][8]; float l[2]; float m[2]; };
__device__ __forceinline__ float qmax4(float v) {
    const auto a = __builtin_amdgcn_permlane32_swap(__float_as_uint(v), __float_as_uint(v), false, false);
    v = fmaxf(__uint_as_float(a[0]), __uint_as_float(a[1]));
    const auto b = __builtin_amdgcn_permlane16_swap(__float_as_uint(v), __float_as_uint(v), false, false);
    return fmaxf(__uint_as_float(b[0]), __uint_as_float(b[1]));
}
__device__ __forceinline__ float qsum4(float v) {
    const auto a = __builtin_amdgcn_permlane32_swap(__float_as_uint(v), __float_as_uint(v), false, false);
    v = __uint_as_float(a[0]) + __uint_as_float(a[1]);
    const auto b = __builtin_amdgcn_permlane16_swap(__float_as_uint(v), __float_as_uint(v), false, false);
    return __uint_as_float(b[0]) + __uint_as_float(b[1]);
}

template <int MODE, int NKT  >
__device__ __forceinline__ void attn_core(const Ctx& C, const bf16* Qw  , const bf16* Kp  , const bf16* VTp  ,
                                          int doff, int gk, int wq0  , int j_lo, int j_hi, const unsigned* selm  , float c2, AttnOut& R) {
    constexpr int NKS = (MODE == MODE_DIFF) ? 2 : 4;
    const int lane = C.lane, lr = lane & 15, lq = lane >> 4, tid = C.tid;
    LAS unsigned char* lds = C.lds;
    bf16x8 qf[2][NKS];
#pragma unroll
    for (int rt = 0; rt < 2; ++rt)
#pragma unroll
        for (int ks = 0; ks < NKS; ++ks) qf[rt][ks] = *(const bf16x8*)(Qw + (size_t)(rt * 16 + lr) * 128 + ks * 32 + 8 * lq);
    unsigned sm[2] = {0xffffffffu, 0xffffffffu}; unsigned wor = 0xffffffffu, wandu = 0xffffffffu;
    if (MODE == MODE_SEL) { sm[0] = selm[wq0 + lr]; sm[1] = selm[wq0 + 16 + lr]; wor = sm[0] | sm[1]; wandu = sm[0] & sm[1];
#pragma unroll
        for (int o = 1; o < 16; o <<= 1) { wor |= __shfl_xor(wor, o); wandu &= __shfl_xor(wandu, o); }
        wor = __builtin_amdgcn_readfirstlane(wor); wandu = __builtin_amdgcn_readfirstlane(wandu); }
#pragma unroll
    for (int rt = 0; rt < 2; ++rt) { R.m[rt] = 0.f; R.l[rt] = 0.f;
#pragma unroll
        for (int vt = 0; vt < 8; ++vt) R.o[rt][vt] = (f32x4){0.f, 0.f, 0.f, 0.f}; }
    f32x4 negm[2] = {(f32x4){0.f, 0.f, 0.f, 0.f}, (f32x4){0.f, 0.f, 0.f, 0.f}}, lacc[2] = {(f32x4){0.f, 0.f, 0.f, 0.f}, (f32x4){0.f, 0.f, 0.f, 0.f}};
    bool seen[2] = {false, false}; bool unseen_any = true;
    const bf16x8 ones = (bf16x8){(short)0x3F80, (short)0x3F80, (short)0x3F80, (short)0x3F80, (short)0x3F80, (short)0x3F80, (short)0x3F80, (short)0x3F80};
#define AT_DMA(j, buf) do { const int kb_ = (j) * 64; \
        _Pragma("unroll") for (int i_ = 0; i_ < 2; ++i_) { const int q_ = C.wave + 8 * i_; \
            const int kr_ = 4 * q_ + (lane >> 4), kc_ = (lane & 15) ^ (kr_ & 15); \
            const int kk_ = 32 * (kr_ >> 5) + 8 * ((kr_ >> 2) & 3) + 4 * ((kr_ >> 4) & 1) + (kr_ & 3);     \
            __builtin_amdgcn_global_load_lds((const unsigned*)(Kp + (size_t)(kb_ + kk_) * 128 + kc_ * 8), (LAS unsigned*)(lds + AT_K_OFF + (buf) * AT_K_BYTES + q_ * 1024), 16, 0, 0); \
            const int vr_ = 8 * q_ + (lane >> 3), vc_ = (lane & 7) ^ ((vr_ >> 1) & 7); \
            __builtin_amdgcn_global_load_lds((const unsigned*)(VTp + (size_t)vr_ * 2048 + kb_ + vc_ * 8), (LAS unsigned*)(lds + AT_V_OFF + (buf) * AT_V_BYTES + q_ * 1024), 16, 0, 0); } } while (0)
    AT_DMA(j_lo, 0);
    for (int j = j_lo; j < j_hi; ++j) {
        const int buf = (j - j_lo) & 1;
        asm volatile("s_waitcnt vmcnt(0)" ::: "memory"); __builtin_amdgcn_s_barrier(); asm volatile("" ::: "memory");
        bf16x8 kf[NKS][NKT];
        { const LAS unsigned char* kl0 = lds + AT_K_OFF + buf * AT_K_BYTES + (32 * gk) * 256;
#pragma unroll
          for (int ks = 0; ks < NKS; ++ks)
#pragma unroll
            for (int kt = 0; kt < NKT; ++kt) kf[ks][kt] = *(const LAS bf16x8*)(kl0 + (kt * 16 + lr) * 256 + ((((doff >> 3) + 4 * ks + lq) ^ lr) << 4)); }
        __builtin_amdgcn_sched_barrier(0);
        if (j + 1 < j_hi) AT_DMA(j + 1, buf ^ 1);
        const int kb = j * 64 + 32 * gk;
        bool act = (kb <= wq0 + 31);
        if (MODE == MODE_WIN) act = act && (kb + 16 * NKT - 1 >= wq0 - 511);
        if (MODE == MODE_SEL) act = act && ((wor >> j) & 1u);
        if (act) {
            const LAS unsigned char* kl = lds + AT_K_OFF + buf * AT_K_BYTES + (32 * gk) * 256; const LAS unsigned char* vl = lds + AT_V_OFF + buf * AT_V_BYTES;
            f32x4 s[NKT][2];
#pragma unroll
            for (int kt = 0; kt < NKT; ++kt) { s[kt][0] = negm[0]; s[kt][1] = negm[1]; }
            u32x4 vw[8];
#pragma unroll
            for (int vt = 0; vt < 8; ++vt) { const int c_ = 4 * gk + lq, s_ = (lr >> 1) & 7; vw[vt] = *(const LAS u32x4*)(vl + (vt * 16 + lr) * 128 + ((c_ ^ s_) << 4)); }
            __builtin_amdgcn_sched_barrier(0);
            bool needmask = (kb + 16 * NKT - 1 > wq0);
            if (MODE == MODE_WIN) needmask = needmask || (kb <= wq0 + 31 - 512 + 1);
            if (MODE == MODE_SEL) needmask = needmask || !((wandu >> j) & 1u);
            bool selonly = false;
            if (MODE == MODE_SEL) selonly = needmask && !(kb + 16 * NKT - 1 > wq0);
            u32x4 pb[2][NKT / 2];
            float alpha_s[2] = {1.f, 1.f};
#define AT_MASK(rt) do { if (selonly) { const bool rowok_ = (sm[rt] >> j) & 1u; \
                    _Pragma("unroll") for (int kt = 0; kt < NKT; ++kt) _Pragma("unroll") for (int r = 0; r < 4; ++r) s[kt][rt][r] = rowok_ ? s[kt][rt][r] : -__builtin_inff(); } \
                else if (needmask) { const int pos_ = wq0 + (rt) * 16 + lr; bool rowok_ = true; if (MODE == MODE_SEL) rowok_ = (sm[rt] >> j) & 1u; \
                    _Pragma("unroll") for (int kt = 0; kt < NKT; ++kt) _Pragma("unroll") for (int r = 0; r < 4; ++r) { const int key_ = kb + 32 * (kt >> 1) + 8 * lq + 4 * (kt & 1) + r; bool ok_ = rowok_ && key_ <= pos_; \
                        if (MODE == MODE_WIN) ok_ = ok_ && (pos_ - key_ < 512); if (!ok_) s[kt][rt][r] = -__builtin_inff(); } } } while (0)
#define AT_REF(rt) do { int hot_ = 0x80000000; \
                _Pragma("unroll") for (int kt = 0; kt < NKT; ++kt) { hot_ = max(max(hot_, __float_as_int(s[kt][rt][0])), __float_as_int(s[kt][rt][1])); hot_ = max(max(hot_, __float_as_int(s[kt][rt][2])), __float_as_int(s[kt][rt][3])); } \
                if (unseen_any || __any(hot_ > 0x41000000)) { \
                    float mx_ = fmaxf(fmaxf(s[0][rt][0], s[0][rt][1]), fmaxf(s[0][rt][2], s[0][rt][3])); \
                    _Pragma("unroll") for (int kt = 1; kt < NKT; ++kt) mx_ = fmaxf(mx_, fmaxf(fmaxf(s[kt][rt][0], s[kt][rt][1]), fmaxf(s[kt][rt][2], s[kt][rt][3]))); \
                    mx_ = qmax4(mx_); \
                    const bool valid_ = mx_ > -__builtin_inff(); \
                    const float delta_ = (valid_ && (mx_ > 8.f || !seen[rt])) ? mx_ : 0.f; \
                    alpha_s[rt] = seen[rt] ? __builtin_amdgcn_exp2f(-delta_) : (delta_ != 0.f ? 0.f : 1.f); \
                    seen[rt] = seen[rt] || valid_; \
                    R.m[rt] += delta_; negm[rt] = (f32x4){-R.m[rt], -R.m[rt], -R.m[rt], -R.m[rt]}; \
                    _Pragma("unroll") for (int kt = 0; kt < NKT; ++kt) s[kt][rt] = s[kt][rt] - delta_; \
                    if (__any(alpha_s[rt] != 1.f)) { lacc[rt] *= alpha_s[rt]; _Pragma("unroll") for (int vt = 0; vt < 8; ++vt) R.o[rt][vt] *= alpha_s[rt]; } } } while (0)
#define AT_ES(rt, i) do { if (NKT == 4) { const int kt_ = (i) >> 1, r0_ = 2 * ((i) & 1); s[kt_][rt][r0_] = __builtin_amdgcn_exp2f(s[kt_][rt][r0_]); s[kt_][rt][r0_ + 1] = __builtin_amdgcn_exp2f(s[kt_][rt][r0_ + 1]); \
                    pb[rt][kt_ >> 1][2 * (kt_ & 1) + ((i) & 1)] = cvt_pk_nop(s[kt_][rt][r0_], s[kt_][rt][r0_ + 1]); } \
                else { const int kt_ = (i) >> 2, r_ = (i) & 3; s[kt_][rt][r_] = __builtin_amdgcn_exp2f(s[kt_][rt][r_]); \
                    if (r_ & 1) pb[rt][0][2 * kt_ + (r_ >> 1)] = cvt_pk_nop(s[kt_][rt][r_ - 1], s[kt_][rt][r_]); } } while (0)
#pragma unroll
            for (int ks = 0; ks < NKS; ++ks)
#pragma unroll
                for (int kt = 0; kt < NKT; ++kt) s[kt][0] = mfma16(kf[ks][kt], qf[0][ks], s[kt][0]);
            AT_MASK(0);
            AT_REF(0);
            __builtin_amdgcn_sched_barrier(0);
#pragma unroll
            for (int ks = 0; ks < NKS; ++ks)
#pragma unroll
                for (int kt = 0; kt < NKT; ++kt) { s[kt][1] = mfma16(kf[ks][kt], qf[1][ks], s[kt][1]); AT_ES(0, ks * NKT + kt); __builtin_amdgcn_sched_barrier(0); }
            AT_MASK(1);
            AT_REF(1);
            if (unseen_any) unseen_any = __any(!seen[0] || !seen[1]);
            __builtin_amdgcn_sched_barrier(0);
#pragma unroll
            for (int vt = 0; vt < 8; ++vt) { R.o[0][vt] = mfma16(__builtin_bit_cast(bf16x8, vw[vt]), __builtin_bit_cast(bf16x8, pb[0][0]), R.o[0][vt]); AT_ES(1, vt); __builtin_amdgcn_sched_barrier(0); }
            lacc[0] = mfma16(ones, __builtin_bit_cast(bf16x8, pb[0][0]), lacc[0]);
#pragma unroll
            for (int vt = 0; vt < 8; ++vt) R.o[1][vt] = mfma16(__builtin_bit_cast(bf16x8, vw[vt]), __builtin_bit_cast(bf16x8, pb[1][0]), R.o[1][vt]);
            lacc[1] = mfma16(ones, __builtin_bit_cast(bf16x8, pb[1][0]), lacc[1]);
#pragma unroll
            for (int kk = 1; kk < NKT / 2; ++kk) {
                __builtin_amdgcn_sched_barrier(0);
#pragma unroll
                for (int vt = 0; vt < 8; ++vt) { const int c_ = 4 * gk + 4 * kk + lq, s_ = (lr >> 1) & 7; vw[vt] = *(const LAS u32x4*)(vl + (vt * 16 + lr) * 128 + ((c_ ^ s_) << 4)); }
                __builtin_amdgcn_sched_barrier(0);
#pragma unroll
                for (int vt = 0; vt < 8; ++vt) {
                    R.o[0][vt] = mfma16(__builtin_bit_cast(bf16x8, vw[vt]), __builtin_bit_cast(bf16x8, pb[0][kk]), R.o[0][vt]);
                    R.o[1][vt] = mfma16(__builtin_bit_cast(bf16x8, vw[vt]), __builtin_bit_cast(bf16x8, pb[1][kk]), R.o[1][vt]); }
                lacc[0] = mfma16(ones, __builtin_bit_cast(bf16x8, pb[0][kk]), lacc[0]); lacc[1] = mfma16(ones, __builtin_bit_cast(bf16x8, pb[1][kk]), lacc[1]); }
#undef AT_MASK
#undef AT_REF
#undef AT_ES
        }
    }
#undef AT_DMA
    R.l[0] = lacc[0][0]; R.l[1] = lacc[1][0];
}
__device__ __forceinline__ void at_put(LAS unsigned char* slot, const AttnOut& R, int lr, int lq) {
    LAS float* xo = (LAS float*)slot; LAS float* xm = xo + 128 * 32;
#pragma unroll
    for (int rt = 0; rt < 2; ++rt) {
#pragma unroll
        for (int vt = 0; vt < 8; ++vt)
#pragma unroll
            for (int r = 0; r < 4; ++r) xo[(vt * 16 + 4 * lq + r) * 32 + rt * 16 + lr] = R.o[rt][vt][r];
        if (lq == 0) { xm[rt * 16 + lr] = R.m[rt]; xm[32 + rt * 16 + lr] = R.l[rt]; } }
}
__device__ __forceinline__ void at_merge(const LAS unsigned char* slot, AttnOut& R, int lr, int lq) {
    const LAS float* xo = (const LAS float*)slot; const LAS float* xm = xo + 128 * 32;
#pragma unroll
    for (int rt = 0; rt < 2; ++rt) { const float m1 = xm[rt * 16 + lr], l1 = xm[32 + rt * 16 + lr];
        const float mn = fmaxf(R.m[rt], m1), a0 = __builtin_amdgcn_exp2f(R.m[rt] - mn), a1 = __builtin_amdgcn_exp2f(m1 - mn);
        R.m[rt] = mn; R.l[rt] = R.l[rt] * a0 + l1 * a1;
#pragma unroll
        for (int vt = 0; vt < 8; ++vt)
#pragma unroll
            for (int r = 0; r < 4; ++r) R.o[rt][vt][r] = R.o[rt][vt][r] * a0 + xo[(vt * 16 + 4 * lq + r) * 32 + rt * 16 + lr] * a1; }
}

constexpr int AT_XH_BYTES = 64 * 32 * 4 + 256;
static_assert(8 * AT_XH_BYTES <= MISC_OFF, "attention LDS (half exchange)");
template <int VT0  >
__device__ __forceinline__ void at_put_half(LAS unsigned char* slot, const AttnOut& R, int lr, int lq) {
    LAS float* xo = (LAS float*)slot; LAS float* xm = xo + 64 * 32;
#pragma unroll
    for (int rt = 0; rt < 2; ++rt) {
#pragma unroll
        for (int v4 = 0; v4 < 4; ++v4)
#pragma unroll
            for (int r = 0; r < 4; ++r) xo[(v4 * 16 + 4 * lq + r) * 32 + rt * 16 + lr] = R.o[rt][VT0 + v4][r];
        if (lq == 0) { xm[rt * 16 + lr] = R.m[rt]; xm[32 + rt * 16 + lr] = R.l[rt]; } }
}
template <int VT0  >
__device__ __forceinline__ void at_merge_half(const LAS unsigned char* slot, AttnOut& R, int lr, int lq) {
    const LAS float* xo = (const LAS float*)slot; const LAS float* xm = xo + 64 * 32;
#pragma unroll
    for (int rt = 0; rt < 2; ++rt) { const float m1 = xm[rt * 16 + lr], l1 = xm[32 + rt * 16 + lr];
        const float mn = fmaxf(R.m[rt], m1), a0 = __builtin_amdgcn_exp2f(R.m[rt] - mn), a1 = __builtin_amdgcn_exp2f(m1 - mn);
        R.m[rt] = mn; R.l[rt] = R.l[rt] * a0 + l1 * a1;
#pragma unroll
        for (int v4 = 0; v4 < 4; ++v4)
#pragma unroll
            for (int r = 0; r < 4; ++r) R.o[rt][VT0 + v4][r] = R.o[rt][VT0 + v4][r] * a0 + xo[(v4 * 16 + 4 * lq + r) * 32 + rt * 16 + lr] * a1; }
}
template <int MODE, int VT0>
__device__ __forceinline__ void nsa_out(unsigned char* ws, AttnOut& R, int b, int h, int wq0, int lr, int lq) {
    const float* GT = (const float*)(ws + WS_GT);
    float* YW = (float*)(ws + WS_YW); const float* YCM = (const float*)(ws + WS_YCM); bf16* Y = (bf16*)(ws + WS_Y);
#pragma unroll
    for (int rt = 0; rt < 2; ++rt) { const int pos = wq0 + rt * 16 + lr; const size_t row = (size_t)b * NT + pos;
        float a = 1.f;
        if (MODE == MODE_WIN) {
            if (pos < 511) { const float mn = fmaxf(R.m[rt], 0.f); a = __builtin_amdgcn_exp2f(R.m[rt] - mn);
                R.l[rt] = R.l[rt] * a + (float)(511 - pos) * __builtin_amdgcn_exp2f(-mn); } }
        const float gl = GT[row * 32 + 3 * h + (MODE == MODE_WIN ? 2 : 1)], gs = (MODE == MODE_WIN ? PROBE_WIN : PROBE_SEL) / (1.f + __expf(-gl)), sc = gs * a / R.l[rt];
#pragma unroll
        for (int v4 = 0; v4 < 4; ++v4) { const int vt = VT0 + v4; const size_t ci = row * 768 + h * 128 + vt * 16 + 4 * lq;
            if (MODE == MODE_WIN) *(f32x4*)(YW + ci) = R.o[rt][vt] * sc;
            else { const f32x4 t = *(const f32x4*)(YW + ci) + *(const f32x4*)(YCM + ci) + R.o[rt][vt] * sc;
                u32x2 w; w.x = pg8::cvt_pk_bf16(t[0], t[1]); w.y = pg8::cvt_pk_bf16(t[2], t[3]);
                *(u32x2*)(Y + row * 2048 + 1280 + h * 128 + vt * 16 + 4 * lq) = w; } } }
}

__device__ __forceinline__ void diff_item(const Ctx& C, const Params& p, int l, int item) {
    unsigned char* ws = p.ws; const float* small = (const float*)(ws + WS_SMALL);
    const int qb = 15 - item / 16, bh = item % 16, b = bh >> 2, h = bh & 3;
    const int q0 = qb * 128, c = C.wave >> 2, wr = C.wave & 3, wq0 = q0 + wr * 32;
    const bf16* P = (const bf16*)(ws + WS_P);
    const bf16* Qw = P + (size_t)(HD_AQ + h) * HDSZ + ((size_t)b * NT + wq0) * 128 + 64 * c;
    const bf16* Kp = P + (size_t)(HD_AK + h) * HDSZ + (size_t)b * NT * 128;
    const bf16* VTp = (const bf16*)(ws + WS_VT) + (size_t)(h * 4 + b) * 128 * 2048;
    AttnOut R;
    attn_core<MODE_DIFF, 4>(C, Qw, Kp, VTp, 64 * c, 0, wq0, 0, (q0 + 128) / 64, nullptr, 0.125f * LOG2E, R);
    const int lr = C.lane & 15, lq = C.lane >> 4;
    __syncthreads();
    if (c == 1) at_put(C.lds + wr * AT_X_BYTES, R, lr, lq);
    __syncthreads();
    if (c == 0) {
        const LAS float* xa = (const LAS float*)(C.lds + wr * AT_X_BYTES);
        const float lam = small[l], osc = 1.f - (0.8f - 0.6f * expf(-0.3f * (float)l));
        const float* gain = p.da_norm + (size_t)l * 512 + h * 128;
        bf16* Y = (bf16*)(ws + WS_Y);
#pragma unroll
        for (int rt = 0; rt < 2; ++rt) { const int q = rt * 16 + lr;
            const float inv1 = lam / xa[128 * 32 + 32 + q], inv0 = 1.f / R.l[rt];
            f32x4 d[8]; float ss = 0.f;
#pragma unroll
            for (int vt = 0; vt < 8; ++vt)
#pragma unroll
                for (int r = 0; r < 4; ++r) { const int xi = (vt * 16 + 4 * lq + r) * 32 + q; const float dv = R.o[rt][vt][r] * inv0 - xa[xi] * inv1; d[vt][r] = dv; ss += dv * dv; }
            ss += __shfl_xor(ss, 16); ss += __shfl_xor(ss, 32);
            const float rs = rsqrtf(ss * (1.f / 128.f) + EPS) * osc;
            bf16* yr = Y + ((size_t)b * NT + wq0 + q) * 2048 + h * 128 + 4 * lq;
#pragma unroll
            for (int vt = 0; vt < 8; ++vt) { const f32x4 g4 = *(const f32x4*)(gain + vt * 16 + 4 * lq);
                u32x2 w; w.x = pg8::cvt_pk_bf16(d[vt][0] * rs * g4[0], d[vt][1] * rs * g4[1]); w.y = pg8::cvt_pk_bf16(d[vt][2] * rs * g4[2], d[vt][3] * rs * g4[3]);
                *(u32x2*)(yr + vt * 16) = w; } }
    }
}
template <int MODE>
__device__ __forceinline__ void nsa_item(const Ctx& C, const Params& p, int item) {
    unsigned char* ws = p.ws;
    const int qb = 15 - item / 24, bh = item % 24, b = bh / 6, h = bh % 6, g = h / 3;
    const int q0 = qb * 128, gk = C.wave >> 2, wr = C.wave & 3, wq0 = q0 + wr * 32;
    const bf16* P = (const bf16*)(ws + WS_P);
    const bf16* Qw = P + (size_t)(HD_CQ + h) * HDSZ + ((size_t)b * NT + wq0) * 128;
    const bf16* Kp = P + (size_t)((MODE == MODE_WIN ? HD_CKW : HD_CKS) + g) * HDSZ + (size_t)b * NT * 128;
    const bf16* VTp = (const bf16*)(ws + WS_VT) + (size_t)(((MODE == MODE_WIN ? 6 : 4) + g) * 4 + b) * 128 * 2048;
    const unsigned* selm = (const unsigned*)(ws + WS_SELM) + (size_t)(b * 2 + g) * NT;
    int j_lo = 0; if (MODE == MODE_WIN) { const int lo = q0 - 511; j_lo = lo > 0 ? lo / 64 : 0; }
    AttnOut R;
    attn_core<MODE, 2>(C, Qw, Kp, VTp, 0, gk, wq0, j_lo, (q0 + 128) / 64, selm, 0.08838834764831845f * LOG2E, R);
    const int lr = C.lane & 15, lq = C.lane >> 4;
    __syncthreads();
    if (gk == 0) at_put_half<4>(C.lds + C.wave * AT_XH_BYTES, R, lr, lq); else at_put_half<0>(C.lds + C.wave * AT_XH_BYTES, R, lr, lq);
    __syncthreads();
    if (gk == 0) { at_merge_half<0>(C.lds + (C.wave ^ 4) * AT_XH_BYTES, R, lr, lq); nsa_out<MODE, 0>(ws, R, b, h, wq0, lr, lq); }
    else { at_merge_half<4>(C.lds + (C.wave ^ 4) * AT_XH_BYTES, R, lr, lq); nsa_out<MODE, 4>(ws, R, b, h, wq0, lr, lq); }
}

constexpr int CM_LD = 136, CM_K_OFF = 0, CM_V_OFF = 128 * CM_LD * 2, CM_W_OFF = 2 * 128 * CM_LD * 2, CM_W_BYTES = 16 * CM_LD * 2 + 2048;
static_assert(16 * CM_LD * 2 >= 2 * 16 * 32 * 4 && CM_W_OFF + 8 * CM_W_BYTES <= MISC_OFF, "cmp LDS");
__device__ __forceinline__ void cmp_item(const Ctx& C, const Params& p, int item) {
    unsigned char* ws = p.ws;
    const int rt = item & 1, qb = (item >> 1) & 7, bg = item >> 4, b = bg >> 1, g = bg & 1;
    const int lane = C.lane, lr = lane & 15, lq = lane >> 4, tid = C.tid;
    LAS unsigned char* lds = C.lds;
    const bf16* KC = (const bf16*)(ws + WS_KC) + (size_t)bg * 128 * 128; const bf16* VCT = (const bf16*)(ws + WS_KC) + (size_t)(8 + bg) * 128 * 128;
    for (int c = tid; c < 2048; c += 512) { const int row = c >> 4, ch = (c & 15) * 8;
        *(LAS u32x4*)(lds + CM_K_OFF + (row * CM_LD + ch) * 2) = *(const u32x4*)(KC + row * 128 + ch);
        *(LAS u32x4*)(lds + CM_V_OFF + (row * CM_LD + ch) * 2) = *(const u32x4*)(VCT + row * 128 + ch); }
    __syncthreads();
    const bf16* P = (const bf16*)(ws + WS_P);
    const float* GT = (const float*)(ws + WS_GT); float* YC = (float*)(ws + WS_YCM);
    unsigned* SELM = (unsigned*)(ws + WS_SELM) + (size_t)bg * NT;
    LAS unsigned char* pw = lds + CM_W_OFF + C.wave * CM_W_BYTES;
    LAS float* gsum = (LAS float*)pw; LAS float* glast = gsum + 16 * 32; LAS float* scr = (LAS float*)(pw + 16 * CM_LD * 2);
    const float c2 = 0.08838834764831845f * LOG2E;
    {
        const int t0 = qb * 256 + C.wave * 32 + rt * 16;
        f32x4 psum[8];
#pragma unroll
        for (int kt = 0; kt < 8; ++kt) psum[kt] = (f32x4){0.f, 0.f, 0.f, 0.f};
        for (int jh = 0; jh < 3; ++jh) {
            const int h = g * 3 + jh;
            const bf16* Qw = P + (size_t)(HD_CQ + h) * HDSZ + ((size_t)b * NT + t0) * 128;
            bf16x8 qf[4];
#pragma unroll
            for (int ks = 0; ks < 4; ++ks) qf[ks] = *(const bf16x8*)(Qw + (size_t)lr * 128 + ks * 32 + 8 * lq);
            f32x4 s[8];
#pragma unroll
            for (int kt = 0; kt < 8; ++kt) s[kt] = (f32x4){0.f, 0.f, 0.f, 0.f};
#pragma unroll
            for (int ks = 0; ks < 4; ++ks) { bf16x8 kf[8];
#pragma unroll
                for (int kt = 0; kt < 8; ++kt) kf[kt] = *(const LAS bf16x8*)(lds + CM_K_OFF + ((kt * 16 + lr) * CM_LD + ks * 32 + 8 * lq) * 2);
                __builtin_amdgcn_sched_barrier(0);
#pragma unroll
                for (int kt = 0; kt < 8; ++kt) s[kt] = mfma16(qf[ks], kf[kt], s[kt]);
                __builtin_amdgcn_sched_barrier(0); }
#pragma unroll
            for (int r = 0; r < 4; ++r) {
                const int pos = t0 + 4 * lq + r;
                float mx = -__builtin_inff();
#pragma unroll
                for (int kt = 0; kt < 8; ++kt) { const int n = kt * 16 + lr; const bool ok = (16 * n + 31 <= pos) && (n < 127); const float v = ok ? s[kt][r] : -__builtin_inff(); s[kt][r] = v; mx = fmaxf(mx, v); }
                mx = fmaxf(mx, __shfl_xor(mx, 1)); mx = fmaxf(mx, __shfl_xor(mx, 2)); mx = fmaxf(mx, __shfl_xor(mx, 4)); mx = fmaxf(mx, __shfl_xor(mx, 8));
                if (mx == -__builtin_inff()) mx = 0.f;
                float ps = 0.f;
#pragma unroll
                for (int kt = 0; kt < 8; ++kt) { const float pv = __builtin_amdgcn_exp2f(s[kt][r] - mx); s[kt][r] = pv; ps += pv; }
                ps += __shfl_xor(ps, 1); ps += __shfl_xor(ps, 2); ps += __shfl_xor(ps, 4); ps += __shfl_xor(ps, 8);
                const float inv = 1.f / fmaxf(ps, 1e-30f);
#pragma unroll
                for (int kt = 0; kt < 8; ++kt) { const float pv = s[kt][r] * inv; psum[kt][r] += pv; *(LAS unsigned short*)(pw + ((4 * lq + r) * CM_LD + kt * 16 + lr) * 2) = (unsigned short)f2bf(pv); }
            }
            LDS_WAIT();
            f32x4 o[8];
#pragma unroll
            for (int vt = 0; vt < 8; ++vt) o[vt] = (f32x4){0.f, 0.f, 0.f, 0.f};
#pragma unroll
            for (int kk = 0; kk < 4; ++kk) { const bf16x8 pf = *(const LAS bf16x8*)(pw + (lr * CM_LD + kk * 32 + 8 * lq) * 2); bf16x8 vf[8];
#pragma unroll
                for (int vt = 0; vt < 8; ++vt) vf[vt] = *(const LAS bf16x8*)(lds + CM_V_OFF + ((vt * 16 + lr) * CM_LD + kk * 32 + 8 * lq) * 2);
                __builtin_amdgcn_sched_barrier(0);
#pragma unroll
                for (int vt = 0; vt < 8; ++vt) o[vt] = mfma16(pf, vf[vt], o[vt]);
                __builtin_amdgcn_sched_barrier(0); }
#pragma unroll
            for (int r = 0; r < 4; ++r) { const size_t row = (size_t)b * NT + t0 + 4 * lq + r;
                const float gl = GT[row * 32 + 3 * h + 0], gs = PROBE_CMP / (1.f + __expf(-gl));
#pragma unroll
                for (int vt = 0; vt < 8; ++vt) { const size_t ci = row * 768 + h * 128 + vt * 16 + lr; YC[ci] = o[vt][r] * gs; } }
            LDS_WAIT();
        }
#pragma unroll
        for (int kt = 0; kt < 8; ++kt)
#pragma unroll
            for (int r = 0; r < 4; ++r) { float v = psum[kt][r]; const float own = v; v += __shfl_xor(v, 1); v += __shfl_xor(v, 2);
                const int q = kt * 4 + (lr >> 2), row = 4 * lq + r;
                if ((lr & 3) == 0) gsum[row * 32 + q] = v;
                if ((lr & 3) == 3) glast[row * 32 + q] = own; }
        LDS_WAIT();
        unsigned mymask[8];
#pragma unroll
        for (int it = 0; it < 8; ++it) { const int row = it * 2 + (lane >> 5), sblk = lane & 31, pos = t0 + row, cur = pos >> 6;
            float imp = gsum[row * 32 + sblk]; if (sblk > 0) imp += glast[row * 32 + sblk - 1];
            const bool valid = sblk <= cur, forced = (sblk == 0) || (sblk == cur) || (sblk == cur - 1);
            const float sc = valid ? imp + (forced ? 1.0e4f : 0.f) : -__builtin_inff();
            scr[row * 32 + sblk] = sc;
            LDS_WAIT();
            int cnt = 0;
            for (int s2 = 0; s2 < 32; ++s2) { const float o2 = scr[row * 32 + s2]; cnt += (o2 > sc || (o2 == sc && s2 < sblk)) ? 1 : 0; }
            const unsigned long long bal = __ballot(valid && cnt < 16);
            mymask[it] = (lane >> 5) ? (unsigned)(bal >> 32) : (unsigned)bal; }
#pragma unroll
        for (int it = 0; it < 8; ++it) if ((lane & 31) == 0) SELM[t0 + it * 2 + (lane >> 5)] = mymask[it];
        LDS_WAIT();
    }
}

__device__ __forceinline__ void c2_task(const Ctx& C, const Params& p, int l, int task) {
    unsigned char* ws = p.ws;
    const int nb = task & 7, g = (task >> 3) & 1, b = (task >> 4) & 3, kv = task >> 6;
    const float* HC = (const float*)(ws + WS_HC); const float* pbp = (const float*)(ws + WS_SMALL) + 8192 + (size_t)(l * 2 + kv) * 32 * 256;
    LAS float* pb = (LAS float*)(C.lds + 16384);
    if (C.tid < 256) { float a = 0.f; for (int sl = 0; sl < 32; ++sl) a += pbp[sl * 256 + C.tid]; pb[C.tid] = a; }
    __syncthreads();
    const bf16* W2T = (const bf16*)(ws + WS_W + (size_t)l * WL_SZ + WL_W2) + (size_t)kv * 128 * 256;
    LAS bf16* hid = (LAS bf16*)C.lds;
    const int rbase = kv * 1024 + g * 512 + b * 128;
    for (int e = C.tid; e < 16 * 256; e += 512) { const int i = e >> 8, c = e & 255, n = nb * 16 + i;
        float v = 0.f;
        if (n < 127) { const float x = HC[(size_t)(rbase + n) * 512 + c] + HC[(size_t)(rbase + n + 1) * 512 + 256 + c] + pb[c];
            v = 0.5f * x * (1.f + tanhf(0.7978845608028654f * (x + 0.044715f * x * x * x))); }
        hid[i * 264 + c] = (bf16)f2bf(v); }
    __syncthreads();
    const int lr = C.lane & 15, lq = C.lane >> 4, dt = C.wave;
    f32x4 acc = (f32x4){0.f, 0.f, 0.f, 0.f};
#pragma unroll
    for (int ks = 0; ks < 8; ++ks) acc = mfma16(*(const LAS bf16x8*)(hid + lr * 264 + ks * 32 + 8 * lq), *(const bf16x8*)(W2T + (size_t)(dt * 16 + lr) * 256 + ks * 32 + 8 * lq), acc);
    bf16* KC = (bf16*)(ws + WS_KC) + (size_t)(b * 2 + g) * 128 * 128; bf16* VCT = (bf16*)(ws + WS_KC) + (size_t)(8 + b * 2 + g) * 128 * 128;
#pragma unroll
    for (int r = 0; r < 4; ++r) { const int n = nb * 16 + 4 * lq + r, d = dt * 16 + lr; const bf16 v = (bf16)f2bf(acc[r]);
        if (kv == 0) KC[n * 128 + d] = v; else VCT[d * 128 + n] = v; }
    __syncthreads();
}

constexpr int HG_TOT = 0, HG_ECM = 2048, HG_RED = 2560, HG_LD = 136, HG_SLD = 72;
constexpr int HG_QM = 4096, HG_KM = HG_QM + 64 * HG_LD * 2, HG_SC = HG_KM + 64 * HG_LD * 2, HG_VT = HG_SC + 64 * HG_SLD * 2, HG_SP = HG_VT + 128 * HG_SLD * 2, HG_END = HG_SP + 128 * HG_LD * 2;
static_assert(HG_END <= MISC_OFF, "HGRN LDS");
__device__ __forceinline__ u32x4 pack8u(const unsigned short* v) { u32x4 w; w.x = v[0] | ((unsigned)v[1] << 16); w.y = v[2] | ((unsigned)v[3] << 16); w.z = v[4] | ((unsigned)v[5] << 16); w.w = v[6] | ((unsigned)v[7] << 16); return w; }
__device__ __forceinline__ void hg1_task(const Ctx& C, const Params& p, int task) {
    unsigned char* ws = p.ws;
    const int n = task & 31, bh = task >> 5, b = bh / 6, h = bh % 6;
    const size_t row0 = (size_t)b * NT + n * 64;
    const bf16* P = (const bf16*)(ws + WS_P);
    const int seg = C.tid >> 7, k = C.tid & 127;
    const float* lf = (const float*)(ws + WS_LF) + ((size_t)h * NM + row0 + seg * 16) * 128 + k;
    const bf16* kp = P + (size_t)(HD_BF + h) * HDSZ + (row0 + seg * 16) * 128 + k; const bf16* ip = P + (size_t)(HD_BI + h) * HDSZ + (row0 + seg * 16) * 128 + k;
    float c[16]; unsigned short kr[16], ir[16];
#pragma unroll
    for (int i = 0; i < 16; ++i) { c[i] = lf[i * 128]; kr[i] = kp[i * 128]; ir[i] = ip[i * 128]; }
#pragma unroll
    for (int i = 1; i < 16; ++i) c[i] += c[i - 1];
    LAS float* tot = (LAS float*)(C.lds + HG_TOT);
    LAS bf16* KT = (LAS bf16*)(C.lds + HG_SP); LAS bf16* VT = (LAS bf16*)(C.lds + HG_VT);
    tot[seg * 128 + k] = c[15];
    __syncthreads();
    const float t0 = tot[k], t1 = tot[128 + k], t2 = tot[256 + k], t3 = tot[384 + k];
    const float off = (seg > 0 ? t0 : 0.f) + (seg > 1 ? t1 : 0.f) + (seg > 2 ? t2 : 0.f), last = ((t0 + t1) + t2) + t3;
    unsigned short kw[16];
#pragma unroll
    for (int i = 0; i < 16; ++i) kw[i] = (unsigned short)f2bf(bf2f(kr[i]) * __expf(last - (c[i] + off)));
    *(LAS u32x4*)(KT + k * HG_SLD + seg * 16) = pack8u(kw); *(LAS u32x4*)(KT + k * HG_SLD + seg * 16 + 8) = pack8u(kw + 8);
    *(LAS u32x4*)(VT + k * HG_SLD + seg * 16) = pack8u(ir); *(LAS u32x4*)(VT + k * HG_SLD + seg * 16 + 8) = pack8u(ir + 8);
    if (seg == 0) ((float*)(ws + WS_DEC))[(size_t)task * 128 + k] = __expf(last);
    __syncthreads();
    const int lr = C.lane & 15, lq = C.lane >> 4, vt = C.wave;
    float* DS = (float*)(ws + WS_DS) + (size_t)task * 128 * 128;
    bf16x8 af[2];
#pragma unroll
    for (int ks = 0; ks < 2; ++ks) af[ks] = *(const LAS bf16x8*)(VT + (vt * 16 + lr) * HG_SLD + ks * 32 + 8 * lq);
    bf16x8 kfr[8][2];
#pragma unroll
    for (int kt = 0; kt < 8; ++kt)
#pragma unroll
        for (int ks = 0; ks < 2; ++ks) kfr[kt][ks] = *(const LAS bf16x8*)(KT + (kt * 16 + lr) * HG_SLD + ks * 32 + 8 * lq);
    __builtin_amdgcn_sched_barrier(0);
#pragma unroll
    for (int kt = 0; kt < 8; ++kt) { f32x4 acc = (f32x4){0.f, 0.f, 0.f, 0.f};
#pragma unroll
        for (int ks = 0; ks < 2; ++ks) acc = mfma16(kfr[kt][ks], af[ks], acc);
        *(f32x4*)(DS + (size_t)(vt * 16 + lr) * 128 + kt * 16 + 4 * lq) = acc; }
    __syncthreads();
}
__device__ __forceinline__ void hg2_scan(const Ctx& C, const Params& p) {
    unsigned char* ws = p.ws;
    const float* DS = (const float*)(ws + WS_DS); const float* DEC = (const float*)(ws + WS_DEC); bf16* SP = (bf16*)(ws + WS_SP);
    constexpr int NE = 24 * 16384; const int stride = C.G * 512;
    for (int base = C.bid * 512 + C.tid; base < NE; base += 3 * stride) {
        const int e0 = base, e1 = base + stride, e2 = base + 2 * stride; const bool v1 = e1 < NE, v2 = e2 < NE;
        const int f1 = v1 ? e1 : e0, f2 = v2 ? e2 : e0;
        const size_t t0 = (size_t)(e0 >> 14) * 32, t1 = (size_t)(f1 >> 14) * 32, t2 = (size_t)(f2 >> 14) * 32; const int k0 = e0 & 16383, k1 = f1 & 16383, k2 = f2 & 16383;
        float S0 = 0.f, S1 = 0.f, S2 = 0.f;
#pragma unroll 8
        for (int n = 0; n < 32; ++n) {
            const float d0 = DS[(t0 + n) * 16384 + k0], d1 = DS[(t1 + n) * 16384 + k1], d2 = DS[(t2 + n) * 16384 + k2];
            const float c0 = DEC[(t0 + n) * 128 + (k0 & 127)], c1 = DEC[(t1 + n) * 128 + (k1 & 127)], c2 = DEC[(t2 + n) * 128 + (k2 & 127)];
            SP[(t0 + n) * 16384 + k0] = (bf16)f2bf(S0); if (v1) SP[(t1 + n) * 16384 + k1] = (bf16)f2bf(S1); if (v2) SP[(t2 + n) * 16384 + k2] = (bf16)f2bf(S2);
            S0 = c0 * S0 + d0; S1 = c1 * S1 + d1; S2 = c2 * S2 + d2; }
    }
}
__device__ __forceinline__ void hg3_task(const Ctx& C, const Params& p, int l, int task) {
    unsigned char* ws = p.ws;
    const int n = task & 31, bh = task >> 5, b = bh / 6, h = bh % 6;
    const size_t row0 = (size_t)b * NT + n * 64;
    const bf16* P = (const bf16*)(ws + WS_P);
    const int seg = C.tid >> 7, k = C.tid & 127;
    const float* lf = (const float*)(ws + WS_LF) + ((size_t)h * NM + row0 + seg * 16) * 128 + k;
    const bf16* kp = P + (size_t)(HD_BF + h) * HDSZ + (row0 + seg * 16) * 128 + k; const bf16* qp = P + (size_t)(HD_BQ + h) * HDSZ + (row0 + seg * 16) * 128 + k;
    const bf16* ip = P + (size_t)(HD_BI + h) * HDSZ + (row0 + seg * 16) * 128 + k; const bf16* gp = P + (size_t)(HD_BG + h) * HDSZ + row0 * 128;
    const bf16* SPg = (const bf16*)(ws + WS_SP) + (size_t)task * 16384;
    float c[16]; unsigned short kr[16], qr[16], ir[16]; bf16x8 spv[4];
#pragma unroll
    for (int i = 0; i < 16; ++i) { c[i] = lf[i * 128]; kr[i] = kp[i * 128]; qr[i] = qp[i * 128]; ir[i] = ip[i * 128]; }
#pragma unroll
    for (int q = 0; q < 4; ++q) { const int e = C.tid + q * 512; spv[q] = *(const bf16x8*)(SPg + (e >> 4) * 128 + (e & 15) * 8); }
#pragma unroll
    for (int i = 1; i < 16; ++i) c[i] += c[i - 1];
    LAS float* tot = (LAS float*)(C.lds + HG_TOT); LAS float* ecm = (LAS float*)(C.lds + HG_ECM); LAS float* red = (LAS float*)(C.lds + HG_RED);
    LAS bf16* QM = (LAS bf16*)(C.lds + HG_QM); LAS bf16* KM = (LAS bf16*)(C.lds + HG_KM); LAS bf16* SPl = (LAS bf16*)(C.lds + HG_SP);
    LAS bf16* SC = (LAS bf16*)(C.lds + HG_SC); LAS bf16* VT = (LAS bf16*)(C.lds + HG_VT);
    tot[seg * 128 + k] = c[15];
    __syncthreads();
    unsigned short ggr[4][4]; float gnr[4];
    { const int lr_ = C.lane & 15, lq_ = C.lane >> 4, tt_ = C.wave & 3, vh_ = C.wave >> 2; const float* gain_ = p.hg_norm + (size_t)l * 768 + h * 128;
#pragma unroll
      for (int r = 0; r < 4; ++r)
#pragma unroll
        for (int q = 0; q < 4; ++q) ggr[r][q] = gp[(size_t)(tt_ * 16 + 4 * lq_ + r) * 128 + (vh_ * 4 + q) * 16 + lr_];
#pragma unroll
      for (int q = 0; q < 4; ++q) gnr[q] = gain_[(vh_ * 4 + q) * 16 + lr_]; }
    { const float t0 = tot[k], t1 = tot[128 + k], t2 = tot[256 + k];
      const float off = (seg > 0 ? t0 : 0.f) + (seg > 1 ? t1 : 0.f) + (seg > 2 ? t2 : 0.f), cm = t0 + t1;
#pragma unroll
      for (int i = 0; i < 16; ++i) { const float d = (c[i] + off) - cm; const int t = seg * 16 + i;
          QM[t * HG_LD + k] = (bf16)f2bf(bf2f(qr[i]) * __expf(d)); KM[t * HG_LD + k] = (bf16)f2bf(bf2f(kr[i]) * __expf(-d)); }
      *(LAS u32x4*)(VT + k * HG_SLD + seg * 16) = pack8u(ir); *(LAS u32x4*)(VT + k * HG_SLD + seg * 16 + 8) = pack8u(ir + 8);
      if (seg == 0) ecm[k] = __expf(cm); }
    __syncthreads();
    const int lr = C.lane & 15, lq = C.lane >> 4;
    { const int tt = C.wave >> 1;
        bf16x8 af[4];
#pragma unroll
        for (int ks = 0; ks < 4; ++ks) af[ks] = *(const LAS bf16x8*)(QM + (tt * 16 + lr) * HG_LD + ks * 32 + 8 * lq);
#pragma unroll
        for (int q = 0; q < 2; ++q) { const int st = (C.wave & 1) * 2 + q; f32x4 acc = (f32x4){0.f, 0.f, 0.f, 0.f};
            bf16x8 kf4[4];
#pragma unroll
            for (int ks = 0; ks < 4; ++ks) kf4[ks] = *(const LAS bf16x8*)(KM + (st * 16 + lr) * HG_LD + ks * 32 + 8 * lq);
            __builtin_amdgcn_sched_barrier(0);
#pragma unroll
            for (int ks = 0; ks < 4; ++ks) acc = mfma16(af[ks], kf4[ks], acc);
#pragma unroll
            for (int r = 0; r < 4; ++r) { const int t = tt * 16 + 4 * lq + r, s = st * 16 + lr; SC[t * HG_SLD + s] = (bf16)f2bf(s <= t ? acc[r] : 0.f); } } }
#pragma unroll
    for (int q = 0; q < 4; ++q) { const int e = C.tid + q * 512, v = e >> 4, k0 = (e & 15) * 8; unsigned short w[8];
#pragma unroll
        for (int j = 0; j < 8; ++j) w[j] = (unsigned short)f2bf(bf2f((unsigned short)spv[q][j]) * ecm[k0 + j]);
        *(LAS u32x4*)(SPl + v * HG_LD + k0) = pack8u(w); }
    __syncthreads();
    const int tt = C.wave & 3, vh = C.wave >> 2;
    f32x4 o[4];
#pragma unroll
    for (int q = 0; q < 4; ++q) o[q] = (f32x4){0.f, 0.f, 0.f, 0.f};
    {
        bf16x8 a2[2], vf2[2][4];
#pragma unroll
        for (int ks = 0; ks < 2; ++ks) { a2[ks] = *(const LAS bf16x8*)(SC + (tt * 16 + lr) * HG_SLD + ks * 32 + 8 * lq);
#pragma unroll
            for (int q = 0; q < 4; ++q) vf2[ks][q] = *(const LAS bf16x8*)(VT + ((vh * 4 + q) * 16 + lr) * HG_SLD + ks * 32 + 8 * lq); }
        __builtin_amdgcn_sched_barrier(0);
#pragma unroll
        for (int ks = 0; ks < 2; ++ks)
#pragma unroll
            for (int q = 0; q < 4; ++q) o[q] = mfma16(a2[ks], vf2[ks][q], o[q]);
        __builtin_amdgcn_sched_barrier(0);
#pragma unroll
        for (int kh = 0; kh < 2; ++kh) { bf16x8 a4[2], sf[2][4];
#pragma unroll
            for (int k2 = 0; k2 < 2; ++k2) { const int ks = 2 * kh + k2; a4[k2] = *(const LAS bf16x8*)(QM + (tt * 16 + lr) * HG_LD + ks * 32 + 8 * lq);
#pragma unroll
                for (int q = 0; q < 4; ++q) sf[k2][q] = *(const LAS bf16x8*)(SPl + ((vh * 4 + q) * 16 + lr) * HG_LD + ks * 32 + 8 * lq); }
            __builtin_amdgcn_sched_barrier(0);
#pragma unroll
            for (int k2 = 0; k2 < 2; ++k2)
#pragma unroll
                for (int q = 0; q < 4; ++q) o[q] = mfma16(a4[k2], sf[k2][q], o[q]);
            __builtin_amdgcn_sched_barrier(0); }
    }
    float gg[4][4];
#pragma unroll
    for (int r = 0; r < 4; ++r)
#pragma unroll
        for (int q = 0; q < 4; ++q) gg[r][q] = bf2f(ggr[r][q]);
#pragma unroll
    for (int r = 0; r < 4; ++r) { float ss = 0.f;
#pragma unroll
        for (int q = 0; q < 4; ++q) ss += o[q][r] * o[q][r];
        ss += __shfl_xor(ss, 1); ss += __shfl_xor(ss, 2); ss += __shfl_xor(ss, 4); ss += __shfl_xor(ss, 8);
        if (lr == 0) red[(tt * 16 + 4 * lq + r) * 2 + vh] = ss; }
    __syncthreads();
    bf16* Y = (bf16*)(ws + WS_Y);
#pragma unroll
    for (int r = 0; r < 4; ++r) { const int t = tt * 16 + 4 * lq + r; const float rs = rsqrtf((red[t * 2] + red[t * 2 + 1]) * (1.f / 128.f) + EPS);
#pragma unroll
        for (int q = 0; q < 4; ++q) { const int v = (vh * 4 + q) * 16 + lr; const float g1 = gg[r][q];
            Y[(row0 + t) * 2048 + 512 + h * 128 + v] = (bf16)f2bf(o[q][r] * rs * gnr[q] * (g1 / (1.f + __expf(-g1)))); } }
    __syncthreads();
}

constexpr int NPH = 2 + 8 * NL;
#ifndef MK_PER_PHASE
#define MK_PER_PHASE 0
#endif

__global__ void __launch_bounds__(512, 2) hymba_fwd(Params p) {
    extern __shared__ __attribute__((aligned(16))) unsigned char lds_raw[];
    Ctx C;
    C.lds = (LAS unsigned char*)lds_raw;
    C.tid = threadIdx.x; C.lane = C.tid & 63; C.wave = __builtin_amdgcn_readfirstlane(C.tid >> 6); C.bid = blockIdx.x; C.G = gridDim.x;
    unsigned char* ws = p.ws;
    C.ctl = (unsigned*)(ws + WS_CTL);
    volatile LAS unsigned* misc = (volatile LAS unsigned*)(C.lds + MISC_OFF);
    if (C.tid < 8) misc[C.tid] = 0u;
    __syncthreads();
    const int lo = p.ph_lo, hi = p.ph_hi;
    XcdBarrier bar; bar.bar = C.ctl + CW_BAR; bar.x = 0; bar.st = misc;
    if (hi - lo > 1) bar = xcd_barrier_post(C.ctl + CW_BAR, misc);
#define PH_ON(k) (lo <= (k) && (k) < hi)
#define PH_FRESH() do { int t_ = threadIdx.x, b_ = blockIdx.x; asm volatile("" : "+v"(t_)); asm volatile("" : "+s"(b_)); C.tid = t_; C.lane = t_ & 63; C.wave = __builtin_amdgcn_readfirstlane(t_ >> 6); C.bid = b_; } while (0)
#define PH_SEAM(k) do { if ((k) + 1 < hi) xcd_barrier(bar); } while (0)
#ifndef REP_PRO
#define REP_PRO 1
#endif
#ifndef REP_GEMM
#define REP_GEMM 1
#endif
#ifndef REP_MIX
#define REP_MIX 1
#endif
#ifndef REP_M2
#define REP_M2 1
#endif
#ifndef REP_M3
#define REP_M3 1
#endif
#ifndef REP_M4
#define REP_M4 1
#endif
#ifndef REP_M5
#define REP_M5 1
#endif
#ifndef REP_NORM
#define REP_NORM 1
#endif
#define PH_BEGIN(k, REPN) if (PH_ON(k)) for (int rep = 0; rep < (REPN); ++rep) { PH_FRESH();
#define PH_END(k, REPN) if (rep + 1 < (REPN)) xcd_barrier(bar); else PH_SEAM(k); }

    PH_BEGIN(0, REP_PRO) p0_prologue(C, p); PH_END(0, REP_PRO)

    bf16* XA = (bf16*)(ws + WS_HN); bf16* XB = (bf16*)(ws + WS_XA);
    bf16* Pb = (bf16*)(ws + WS_P); bf16* Yb = (bf16*)(ws + WS_Y); bf16* HF = (bf16*)(ws + WS_HF);
    for (int l = 0; l < NL; ++l) {
        const int k0 = 1 + 8 * l; float* SS = (float*)(ws + WS_SSP);
        unsigned char* wl = ws + WS_W + (size_t)l * WL_SZ;

        unsigned* qc = C.ctl + CW_Q + 512 * (l * 4);
        PH_BEGIN(k0 + 0, REP_GEMM)
            pg8::Gemm g{XA, (const bf16*)(wl + WL_IN), NM, NPAD, ND}; pg8::StaticOrder S; S.init(NM, NPAD, C.G, C.bid);
            LAS float* rtab = (LAS float*)(C.lds + 131072); pg8::Unit u0{0, 0}; (void)S.next(0, u0);
            if (C.tid < 256) rtab[C.tid] = pg8::row_rstd(SS + (size_t)(l * 2) * 8192 * 8, u0.pm * 256 + C.tid);
            __syncthreads();
            pg8::EpiIn E{Pb, (float*)(ws + WS_LF), (float*)(ws + WS_GT), (bf16*)(ws + WS_VT), (const float*)(ws + WS_SMALL) + 4 + l * 768, SS + (size_t)(l * 2) * 8192 * 8, rtab, u0.pm};
            pg8::gemm_phase<pg8::EpiIn, pg8::StaticOrder, true, true>(C.lds, g, S, E);
        PH_END(k0 + 0, REP_GEMM)
        PH_BEGIN(k0 + 1, REP_MIX * REP_M2)
            { pg8::Gemm g{Pb + (size_t)HD_CKC * HDSZ, (const bf16*)(wl + WL_C1), 2048, 1024, 2048}; pg8::CmpOrder S{C.G, C.bid};
              pg8::EpiHc E{(float*)(ws + WS_HC)};
              pg8::gemm_phase<pg8::EpiHc, pg8::CmpOrder, false, true>(C.lds, g, S, E); }
#ifdef PROBE_NOQ16
            if (C.bid >= 16)
#endif
            for (int sub = -1;;) { const int it = q_next(C, qc + 0, 384 + 768, sub); if (it >= 384 + 768) break; PH_FRESH();
                if (it < 384) nsa_item<MODE_WIN>(C, p, it);
                else hg1_task(C, p, it - 384); }
        PH_END(k0 + 1, REP_MIX * REP_M2)
        PH_BEGIN(k0 + 2, REP_MIX * REP_M3)
            for (int t = C.bid; t < 128; t += C.G) c2_task(C, p, l, t);
            PH_FRESH();
            hg2_scan(C, p);
        PH_END(k0 + 2, REP_MIX * REP_M3)
        PH_BEGIN(k0 + 3, REP_MIX * REP_M4)
            for (int sub = -1;;) { const int it = q_next(C, qc + 512, 128 + 256 + 768, sub); if (it >= 128 + 256 + 768) break; PH_FRESH();
                if (it < 128) cmp_item(C, p, it); else if (it < 384) diff_item(C, p, l, it - 128); else hg3_task(C, p, l, it - 384); }
        PH_END(k0 + 3, REP_MIX * REP_M4)
        PH_BEGIN(k0 + 4, REP_MIX * REP_M5)
            for (int sub = -1;;) { const int it = q_next(C, qc + 1024, 384, sub); if (it >= 384) break; PH_FRESH(); nsa_item<MODE_SEL>(C, p, it); }
        PH_END(k0 + 4, REP_MIX * REP_M5)
        PH_BEGIN(k0 + 5, REP_GEMM)
            pg8::Gemm g{Yb, (const bf16*)(wl + WL_OUT), NM, ND, ND}; pg8::StaticOrder S; S.init(NM, ND, C.G, C.bid);
            pg8::EpiRes E{XA, XB, SS + (size_t)(l * 2 + 1) * 8192 * 8};
            pg8::gemm_phase<pg8::EpiRes, pg8::StaticOrder, false, true>(C.lds, g, S, E);
        PH_END(k0 + 5, REP_GEMM)
        PH_BEGIN(k0 + 6, REP_GEMM)
            pg8::Gemm g{XB, (const bf16*)(wl + WL_GU), NM, 2 * DFF, ND}; pg8::StaticOrder S; S.init(NM, 2 * DFF, C.G, C.bid);
            LAS float* rtab = (LAS float*)(C.lds + 131072); pg8::Unit u0{0, 0}; (void)S.next(0, u0);
            if (C.tid < 256) rtab[C.tid] = pg8::row_rstd(SS + (size_t)(l * 2 + 1) * 8192 * 8, u0.pm * 256 + C.tid);
            __syncthreads();
            pg8::EpiGU E{HF, SS + (size_t)(l * 2 + 1) * 8192 * 8, rtab, u0.pm};
            pg8::gemm_phase<pg8::EpiGU, pg8::StaticOrder, true, true>(C.lds, g, S, E);
        PH_END(k0 + 6, REP_GEMM)
        PH_BEGIN(k0 + 7, REP_GEMM)
            pg8::Gemm g{HF, (const bf16*)(wl + WL_DN), NM, ND, DFF}; pg8::StaticOrder S; S.init(NM, ND, C.G, C.bid);
            pg8::EpiRes E{XB, XA, SS + (size_t)(l * 2 + 2) * 8192 * 8};
            pg8::gemm_phase<pg8::EpiRes, pg8::StaticOrder, false, true>(C.lds, g, S, E);
        PH_END(k0 + 7, REP_GEMM)
    }
    if (PH_ON(NPH - 1)) { PH_FRESH(); final_norm_rows(C, XA, p.final_norm, p.out); }
#undef PH_ON
#undef PH_SEAM
}

extern "C" void kernel_launch(void* const* d_in, const int* in_sizes, int n_in, void* d_out, int out_size, void* d_ws, size_t ws_size, hipStream_t stream) {
    static int grid = 0;
    if (grid == 0) {
        if (n_in != 22 || out_size != NM * ND || ws_size < WS_END) { fprintf(stderr, "kernel_launch: unexpected shapes (n_in %d out %d ws %zu need %zu)\n", n_in, out_size, ws_size, (size_t)WS_END); grid = -1; return; }
        int dev = 0, cus = 0, per_cu = 0;
        if (hipGetDevice(&dev) != hipSuccess || hipDeviceGetAttribute(&cus, hipDeviceAttributeMultiprocessorCount, dev) != hipSuccess) { grid = -1; return; }
        if (hipFuncSetAttribute((const void*)hymba_fwd, hipFuncAttributeMaxDynamicSharedMemorySize, LDS_BYTES) != hipSuccess) { fprintf(stderr, "kernel_launch: hipFuncSetAttribute failed\n"); grid = -1; return; }
        if (hipOccupancyMaxActiveBlocksPerMultiprocessor(&per_cu, (const void*)hymba_fwd, 512, LDS_BYTES) != hipSuccess || per_cu < 1) fprintf(stderr, "kernel_launch: occupancy query reports %d\n", per_cu);
        (void)hipGetLastError();
        grid = cus;
    }
    if (grid < 0) return;
    (void)hipMemsetAsync((char*)d_ws + WS_CTL, 0, CTL_ZERO_BYTES, stream);
    Params p{};
    p.x = (const float*)d_in[0]; p.attn_norm = (const float*)d_in[1]; p.w_in = (const float*)d_in[2]; p.lq1 = (const float*)d_in[3]; p.lk1 = (const float*)d_in[4];
    p.lq2 = (const float*)d_in[5]; p.lk2 = (const float*)d_in[6]; p.da_norm = (const float*)d_in[7]; p.hg_gamma = (const float*)d_in[8]; p.hg_norm = (const float*)d_in[9];
    p.pe_k = (const float*)d_in[10]; p.pe_v = (const float*)d_in[11]; p.ck_w1 = (const float*)d_in[12]; p.ck_w2 = (const float*)d_in[13]; p.cv_w1 = (const float*)d_in[14];
    p.cv_w2 = (const float*)d_in[15]; p.w_out = (const float*)d_in[16]; p.ffn_norm = (const float*)d_in[17]; p.w_gate = (const float*)d_in[18]; p.w_up = (const float*)d_in[19];
    p.w_down = (const float*)d_in[20]; p.final_norm = (const float*)d_in[21];
    p.out = (float*)d_out; p.ws = (unsigned char*)d_ws;
#if MK_PER_PHASE
    for (int ph = 0; ph < NPH; ++ph) { p.ph_lo = ph; p.ph_hi = ph + 1; hipLaunchKernelGGL(hymba_fwd, dim3(grid), dim3(512), LDS_BYTES, stream, p); }
#else
    p.ph_lo = 0; p.ph_hi = NPH;
    hipLaunchKernelGGL(hymba_fwd, dim3(grid), dim3(512), LDS_BYTES, stream, p);
#endif
    const hipError_t le = hipPeekAtLastError();
    if (le != hipSuccess) fprintf(stderr, "kernel_launch: launch failed: %s\n", hipGetErrorName(le));
}
#ifdef RES_TEST
#define RT_HEAD extern __shared__ __attribute__((aligned(16))) unsigned char lds_raw[]; Ctx C; C.lds = (LAS unsigned char*)lds_raw; C.tid = threadIdx.x; C.lane = C.tid & 63; C.wave = __builtin_amdgcn_readfirstlane(C.tid >> 6); C.bid = blockIdx.x; C.G = gridDim.x; C.ctl = (unsigned*)p.ws; unsigned char* ws = p.ws; (void)ws;
__global__ void __launch_bounds__(512, 2) t_prologue(Params p) { RT_HEAD p0_prologue(C, p); }
__global__ void __launch_bounds__(512, 2) t_norm(Params p) { RT_HEAD norm_rows(C, p.x, p.attn_norm, (bf16*)ws, nullptr); }
__global__ void __launch_bounds__(512, 2) t_gemm_in(Params p) { RT_HEAD pg8::Gemm g{(bf16*)ws, (const bf16*)(ws + 64), NM, NPAD, ND}; pg8::StaticOrder S; S.init(NM, NPAD, C.G, C.bid);
    pg8::EpiIn E{(bf16*)ws, (float*)(ws + WS_LF), (float*)(ws + WS_GT), (bf16*)(ws + WS_VT), (const float*)(ws + WS_SMALL), (const float*)ws, (const LAS float*)C.lds, 0}; pg8::gemm_phase<pg8::EpiIn, pg8::StaticOrder, true, true>(C.lds, g, S, E); }
__global__ void __launch_bounds__(512, 2) t_gemm_res(Params p) { RT_HEAD pg8::Gemm g{(bf16*)ws, (const bf16*)(ws + 64), NM, ND, ND}; pg8::StaticOrder S; S.init(NM, ND, C.G, C.bid);
    pg8::EpiRes E{(bf16*)ws, (bf16*)ws, (float*)ws}; pg8::gemm_phase<pg8::EpiRes, pg8::StaticOrder, false, true>(C.lds, g, S, E); }
__global__ void __launch_bounds__(512, 2) t_gemm_gu(Params p) { RT_HEAD pg8::Gemm g{(bf16*)ws, (const bf16*)(ws + 64), NM, 2 * DFF, ND}; pg8::StaticOrder S; S.init(NM, 2 * DFF, C.G, C.bid);
    pg8::EpiGU E{(bf16*)p.out, (const float*)ws, (const LAS float*)C.lds, 0}; pg8::gemm_phase<pg8::EpiGU, pg8::StaticOrder, true, true>(C.lds, g, S, E); }
__global__ void __launch_bounds__(512, 2) t_gemm_hc(Params p) { RT_HEAD pg8::Gemm g{(bf16*)ws, (const bf16*)(ws + 64), 2048, 1024, 2048}; pg8::CmpOrder S{C.G, C.bid};
    pg8::EpiHc E{(float*)p.out}; pg8::gemm_phase<pg8::EpiHc, pg8::CmpOrder, false, true>(C.lds, g, S, E); }
__global__ void __launch_bounds__(512, 2) t_diff(Params p) { RT_HEAD diff_item(C, p, p.ph_lo, C.bid); }
__global__ void __launch_bounds__(512, 2) t_win(Params p) { RT_HEAD nsa_item<MODE_WIN>(C, p, C.bid); }
__global__ void __launch_bounds__(512, 2) t_sel(Params p) { RT_HEAD nsa_item<MODE_SEL>(C, p, C.bid); }
__global__ void __launch_bounds__(512, 2) t_cmp(Params p) { RT_HEAD cmp_item(C, p, C.bid); }
__global__ void __launch_bounds__(512, 2) t_c2(Params p) { RT_HEAD c2_task(C, p, p.ph_lo, C.bid); }
__global__ void __launch_bounds__(512, 2) t_hg1(Params p) { RT_HEAD hg1_task(C, p, C.bid); }
__global__ void __launch_bounds__(512, 2) t_hg2(Params p) { RT_HEAD hg2_scan(C, p); }
__global__ void __launch_bounds__(512, 2) t_hg3(Params p) { RT_HEAD hg3_task(C, p, p.ph_lo, C.bid); }
#endif
```

```cpp
#define MK_PER_PHASE 0
#include <hip/hip_runtime.h>
#include <cstdio>
#include <cstdint>
namespace pg8 {
#define PG8_LAS __attribute__((address_space(3)))
typedef unsigned short bf16_t;
typedef short bf16x8 __attribute__((ext_vector_type(8)));
typedef float f32x4 __attribute__((ext_vector_type(4)));
typedef unsigned u32x4 __attribute__((ext_vector_type(4)));
constexpr int BM = 256, BK = 64, HALF = 128, HTB = HALF * BK * 2  , STAGE_BYTES = 8 * HTB, NXCD = 8, WGM = 8;

__host__ __device__ __forceinline__ int lds_byte(int r, int c) { const int st = (r >> 4) * 2 + (c >> 5), rr = r & 15, cc = c & 31, ob = rr * 64 + cc * 2; return st * 1024 + (ob ^ (((ob >> 9) & 1) << 5)); }
__host__ __device__ __forceinline__ void stage_rc(int b, int& R, int& C) { const int st = b / 1024, sb = b % 1024, swz = sb ^ (((sb >> 9) & 1) << 5); R = (st >> 1) * 16 + swz / 64; C = (st & 1) * 32 + (swz % 64) / 2; }
__host__ __device__ __forceinline__ int perm32(int rho) { const int n = rho >> 4, i = rho & 15; return 8 * (i >> 2) + 4 * n + (i & 3); }

struct Unit { int pm, pn; };
struct Gemm { const bf16_t* A; const bf16_t* Bt; int M, N, K; };

struct StaticOrder {
    int nM, nN, nwg, G, c;
    __host__ __device__ __forceinline__ void init(int M, int N, int G_, int c_) { nM = M / BM; nN = N / BM; nwg = nM * nN; G = G_; c = c_; }
    __host__ __device__ __forceinline__ bool next(int i, Unit& u) const {
        const long L = (long)i * G + c; if (L >= nwg) return false;
        int wgid = (int)L; { const int q = nwg / NXCD, r = nwg % NXCD, xcd = wgid % NXCD, off = wgid / NXCD; wgid = (xcd < r ? xcd * (q + 1) : r * (q + 1) + (xcd - r) * q) + off; }
        const int nig = WGM * nN, gid = wgid / nig, fm = gid * WGM, gsz = (nM - fm) < WGM ? (nM - fm) : WGM;
        u.pm = fm + ((wgid % nig) % gsz); u.pn = (wgid % nig) / gsz; return true;
    }
    __device__ __forceinline__ void a_ready(const Unit&) const {}
    __device__ __forceinline__ void done(const Unit&) const {}
};

typedef __bf16 bf16x2n __attribute__((ext_vector_type(2)));
__device__ __forceinline__ unsigned cvt_pk_bf16(float lo, float hi) { bf16x2n v; v[0] = (__bf16)lo; v[1] = (__bf16)hi; return __builtin_bit_cast(unsigned, v); }
__device__ __forceinline__ u32x4 pack8f(const f32x4 a, const f32x4 b) { u32x4 w; w.x = cvt_pk_bf16(a[0], a[1]); w.y = cvt_pk_bf16(a[2], a[3]); w.z = cvt_pk_bf16(b[0], b[1]); w.w = cvt_pk_bf16(b[2], b[3]); return w; }
__device__ __forceinline__ bf16_t f2bf1(float f) { return __builtin_bit_cast(bf16_t, (__bf16)f); }

__device__ __forceinline__ float row_rstd(const float* ssp, int row) { const f32x4 a = *(const f32x4*)(ssp + (size_t)row * 8), b = *(const f32x4*)(ssp + (size_t)row * 8 + 4);
    return rsqrtf((((a[0] + a[1]) + (a[2] + a[3])) + ((b[0] + b[1]) + (b[2] + b[3]))) * (1.f / 2048.f) + 1e-6f); }
struct EpiIn {
    static constexpr bool PERM = true, AFTER_DRAIN = false;
    bf16_t* P; float* LF; float* GT; bf16_t* VT; const float* lb; const float* ss; const PG8_LAS float* rtab; int pm0;
    __device__ __forceinline__ void operator()(const f32x4 (&acc_)[2][2][4][2], const Unit& u, int wr, int wc, int fr, int fq) const {
        const int row0 = u.pm * BM + wr * 64 + fr;
        const int d0 = wc * 32 + 8 * fq;
        f32x4 acc[2][2][4][2];
#pragma unroll
        for (int ai = 0; ai < 2; ++ai)
#pragma unroll
            for (int m = 0; m < 4; ++m) { const float rs = (u.pm == pm0) ? rtab[wr * 64 + fr + ai * HALF + m * 16] : row_rstd(ss, row0 + ai * HALF + m * 16);
#pragma unroll
                for (int bj = 0; bj < 2; ++bj) { acc[ai][bj][m][0] = acc_[ai][bj][m][0] * rs; acc[ai][bj][m][1] = acc_[ai][bj][m][1] * rs; } }
        if (u.pn == 27) {
            if (wc == 0) {
#pragma unroll
                for (int ai = 0; ai < 2; ++ai)
#pragma unroll
                    for (int m = 0; m < 4; ++m) { float* g = GT + (size_t)(row0 + ai * HALF + m * 16) * 32 + 8 * fq; *(f32x4*)g = acc[ai][0][m][0]; *(f32x4*)(g + 4) = acc[ai][0][m][1]; }
            }
            return;
        }
#pragma unroll
        for (int bj = 0; bj < 2; ++bj) {
            const int hd = 2 * u.pn + bj;
            int kind = 0, vh = 0;
            if (hd >= 8 && hd < 12) { kind = 2; vh = hd - 8; } else if (hd == 48 || hd == 49) { kind = 2; vh = hd - 44; } else if (hd == 52 || hd == 53) { kind = 2; vh = hd - 46; } else if (hd >= 12 && hd < 18) kind = 1;
            if (kind == 2) {
#pragma unroll
                for (int ai = 0; ai < 2; ++ai)
#pragma unroll
                    for (int m = 0; m < 4; ++m) { const int row = row0 + ai * HALF + m * 16, b = row >> 11, t = row & 2047;
                        bf16_t* dst = VT + ((size_t)(vh * 4 + b) * 128 + d0) * 2048 + t;
#pragma unroll
                        for (int j = 0; j < 4; ++j) { dst[(size_t)j * 2048] = f2bf1(acc[ai][bj][m][0][j]); dst[(size_t)(4 + j) * 2048] = f2bf1(acc[ai][bj][m][1][j]); } }
            } else if (kind == 1) {
                const f32x4 l0 = *(const f32x4*)(lb + (hd - 12) * 128 + d0), l1 = *(const f32x4*)(lb + (hd - 12) * 128 + d0 + 4);
#pragma unroll
                for (int ai = 0; ai < 2; ++ai)
#pragma unroll
                    for (int m = 0; m < 4; ++m) { const int row = row0 + ai * HALF + m * 16;
                        f32x4 lf0, lf1, k0, k1;
#pragma unroll
                        for (int j = 0; j < 4; ++j) {
                            { const float z = acc[ai][bj][m][0][j], e = __expf(-z), s = __builtin_amdgcn_rcpf(1.f + e), oms = e * s, lbv = l0[j]; lf0[j] = __logf(lbv + (1.f - lbv) * s); k0[j] = (1.f - lbv) * oms; }
                            { const float z = acc[ai][bj][m][1][j], e = __expf(-z), s = __builtin_amdgcn_rcpf(1.f + e), oms = e * s, lbv = l1[j]; lf1[j] = __logf(lbv + (1.f - lbv) * s); k1[j] = (1.f - lbv) * oms; } }
                        float* lp = LF + ((size_t)(hd - 12) * 8192 + row) * 128 + d0; *(f32x4*)lp = lf0; *(f32x4*)(lp + 4) = lf1;
                        *(u32x4*)(P + ((size_t)hd * 8192 + row) * 128 + d0) = pack8f(k0, k1); }
            } else {
                const float qs = (hd < 4) ? 0.125f * 1.4426950408889634f : (hd >= 36 && hd < 42) ? 0.08838834764831845f * 1.4426950408889634f : 1.f;
#pragma unroll
                for (int ai = 0; ai < 2; ++ai)
#pragma unroll
                    for (int m = 0; m < 4; ++m) { const int row = row0 + ai * HALF + m * 16;
                        *(u32x4*)(P + ((size_t)hd * 8192 + row) * 128 + d0) = pack8f(acc[ai][bj][m][0] * qs, acc[ai][bj][m][1] * qs); }
            }
        }
    }
};
struct EpiRes {
    static constexpr bool PERM = false, AFTER_DRAIN = true;
    const bf16_t* baseh; bf16_t* xo; float* ssp;
    __device__ __forceinline__ void fused(f32x4 (&acc)[2][2][4][2], const Unit& u, int wr, int wc, int fr, int fq, PG8_LAS unsigned char* lds, int wid, int lane) const {
        typedef unsigned u32x2_ __attribute__((ext_vector_type(2)));
        PG8_LAS float* T = (PG8_LAS float*)lds;
        const int rl0 = wr * 64 + fr, col0 = u.pn * BM + wc * 32 + 4 * fq;
#pragma unroll
        for (int ai = 0; ai < 2; ++ai)
#pragma unroll
            for (int m = 0; m < 4; ++m) { const int rl = rl0 + ai * HALF + m * 16; const size_t off = (size_t)(u.pm * BM + rl) * 2048 + col0; float q = 0.f;
#pragma unroll
                for (int bj = 0; bj < 2; ++bj)
#pragma unroll
                    for (int n = 0; n < 2; ++n) { const size_t o = off + bj * HALF + n * 16; f32x4 b;
                        { const u32x2_ hb = *(const u32x2_*)(baseh + o); b[0] = __builtin_bit_cast(float, hb.x << 16); b[1] = __builtin_bit_cast(float, hb.x & 0xffff0000u); b[2] = __builtin_bit_cast(float, hb.y << 16); b[3] = __builtin_bit_cast(float, hb.y & 0xffff0000u); }
                        const f32x4 v = b + acc[ai][bj][m][n];
                        u32x2_ w; w.x = cvt_pk_bf16(v[0], v[1]); w.y = cvt_pk_bf16(v[2], v[3]); *(u32x2_*)(xo + o) = w;
                        q += (v[0] * v[0] + v[1] * v[1]) + (v[2] * v[2] + v[3] * v[3]); }
                q += __shfl_xor(q, 16); q += __shfl_xor(q, 32);
                if (fq == 0) T[rl * 4 + wc] = q; }
        asm volatile("s_waitcnt lgkmcnt(0)" ::: "memory"); __builtin_amdgcn_s_barrier(); asm volatile("" ::: "memory");
        const int t = wid * 64 + lane;
        if (t < 256) { const f32x4 v = *(const PG8_LAS f32x4*)(T + t * 4); ssp[(size_t)(u.pm * BM + t) * 8 + u.pn] = (v[0] + v[1]) + (v[2] + v[3]); }
    }
};
struct EpiGU {
    static constexpr bool PERM = true, AFTER_DRAIN = false;
    bf16_t* H; const float* ss; const PG8_LAS float* rtab; int pm0;
    __device__ __forceinline__ void operator()(const f32x4 (&acc)[2][2][4][2], const Unit& u, int wr, int wc, int fr, int fq) const {
        const int row0 = u.pm * BM + wr * 64 + fr, col0 = u.pn * 128 + wc * 32 + 8 * fq;
#pragma unroll
        for (int ai = 0; ai < 2; ++ai)
#pragma unroll
            for (int m = 0; m < 4; ++m) { f32x4 h0, h1; const float rs = (u.pm == pm0) ? rtab[wr * 64 + fr + ai * HALF + m * 16] : row_rstd(ss, row0 + ai * HALF + m * 16);
#pragma unroll
                for (int j = 0; j < 4; ++j) { const float g0 = acc[ai][0][m][0][j] * rs, g1 = acc[ai][0][m][1][j] * rs;
                    h0[j] = g0 * __builtin_amdgcn_rcpf(1.f + __expf(-g0)) * (acc[ai][1][m][0][j] * rs); h1[j] = g1 * __builtin_amdgcn_rcpf(1.f + __expf(-g1)) * (acc[ai][1][m][1][j] * rs); }
                *(u32x4*)(H + (size_t)(row0 + ai * HALF + m * 16) * 5632 + col0) = pack8f(h0, h1); }
    }
};
struct EpiHc {
    static constexpr bool PERM = false, AFTER_DRAIN = false;
    float* HC;
    __device__ __forceinline__ void operator()(const f32x4 (&acc)[2][2][4][2], const Unit& u, int wr, int wc, int fr, int fq) const {
        const int row0 = u.pm * BM + wr * 64 + fr, col0 = (u.pn & 1) * BM + wc * 32 + 4 * fq;
#pragma unroll
        for (int ai = 0; ai < 2; ++ai)
#pragma unroll
            for (int m = 0; m < 4; ++m) { float* rp = HC + (size_t)(row0 + ai * HALF + m * 16) * 512 + col0;
#pragma unroll
                for (int bj = 0; bj < 2; ++bj)
#pragma unroll
                    for (int n = 0; n < 2; ++n) *(f32x4*)(rp + bj * HALF + n * 16) = acc[ai][bj][m][n]; }
    }
};
struct CmpOrder {
    int G, c;
    __device__ __forceinline__ bool next(int i, Unit& u) const { const int L = i * G + c; if (L >= 16) return false; u.pm = L >> 1; u.pn = 2 * (u.pm >> 2) + (L & 1); return true; }
    __device__ __forceinline__ void a_ready(const Unit&) const {}
    __device__ __forceinline__ void done(const Unit&) const {}
};
template <class Epi, class Sched, bool ALIGN_EPI = false, bool SP2 = false>
__device__ __forceinline__ void gemm_phase(PG8_LAS unsigned char* lds, const Gemm g, const Sched& S, const Epi& E) {
    int tid_ = threadIdx.x; asm volatile("" : "+v"(tid_)); const int tid = tid_, wid = __builtin_amdgcn_readfirstlane(tid >> 6), lane = tid & 63, wr = wid >> 2, wc = wid & 3, fr = lane & 15, fq = lane >> 4;
    const int K = g.K, nt = K / BK;
    unsigned voffA[2], voffB[2];
#pragma unroll
    for (int i = 0; i < 2; ++i) { int R, C; stage_rc(tid * 16 + i * 8192, R, C); const int Rb = Epi::PERM ? ((R & ~31) + perm32(R & 31)) : R;
        voffA[i] = (unsigned)(R * K + C) * 2u; voffB[i] = (unsigned)(Rb * K + C) * 2u; }
    const size_t kstep = (size_t)(BK * 2);
    const size_t hstep = (size_t)HALF * K * 2;
    const size_t tstep = 2 * hstep;
    const unsigned ldsw = (unsigned)wid * 1024u;
    const int aoff = lds_byte(wr * 64 + fr, fq * 8), boff = lds_byte(wc * 32 + fr, fq * 8);
#define PG8_SA(b, h) (((b) * 2 + (h)) * HTB)
#define PG8_SB(b, h) ((4 + (b) * 2 + (h)) * HTB)
#define PG8_STAGE(bufoff, gbase, voff) do { _Pragma("unroll") for (int _i = 0; _i < 2; ++_i) \
        __builtin_amdgcn_global_load_lds((const unsigned*)((const char*)(gbase) + (voff)[_i]), (PG8_LAS unsigned*)(lds + (bufoff) + ldsw + _i * 8192), 16, 0, 0); } while (0)
#define PG8_LDA(dst, b, h) do { _Pragma("unroll") for (int m = 0; m < 4; ++m) _Pragma("unroll") for (int k = 0; k < 2; ++k) dst[m][k] = *(const PG8_LAS bf16x8*)(lds + PG8_SA(b, h) + aoff + m * 2048 + k * 1024); } while (0)
#define PG8_LDB(dst, b, h) do { _Pragma("unroll") for (int n = 0; n < 2; ++n) _Pragma("unroll") for (int k = 0; k < 2; ++k) dst[n][k] = *(const PG8_LAS bf16x8*)(lds + PG8_SB(b, h) + boff + n * 2048 + k * 1024); } while (0)
#define PG8_MMA(ai, bj, At, Bt) do { __builtin_amdgcn_s_setprio(1); _Pragma("unroll") for (int m = 0; m < 4; ++m) _Pragma("unroll") for (int n = 0; n < 2; ++n) _Pragma("unroll") for (int k = 0; k < 2; ++k) \
        acc[ai][bj][m][n] = __builtin_amdgcn_mfma_f32_16x16x32_bf16(Bt[n][k], At[m][k], acc[ai][bj][m][n], 0, 0, 0); __builtin_amdgcn_s_setprio(0); } while (0)
#define PG8_WAIT_V(n) asm volatile("s_waitcnt vmcnt(" #n ")" ::: "memory")
#define PG8_WAIT_L(n) asm volatile("s_waitcnt lgkmcnt(" #n ")" ::: "memory")
#define PG8_BAR __builtin_amdgcn_s_barrier()
#define PG8_SCHED __builtin_amdgcn_sched_barrier(0)
    Unit cur, nxt; int ui = 0;
    if (!S.next(0, cur)) return;
    f32x4 acc[2][2][4][2];
#pragma unroll
    for (int a = 0; a < 2; ++a)
#pragma unroll
        for (int b = 0; b < 2; ++b)
#pragma unroll
            for (int m = 0; m < 4; ++m)
#pragma unroll
                for (int n = 0; n < 2; ++n) acc[a][b][m][n] = (f32x4){0.f, 0.f, 0.f, 0.f};
    bf16x8 At[4][2], B0[2][2], B1[2][2];
    const char* cA = (const char*)g.A + (size_t)cur.pm * tstep; const char* cB = (const char*)g.Bt + (size_t)cur.pn * tstep;
    S.a_ready(cur);
    if constexpr (SP2) {
        PG8_STAGE(PG8_SB(0, 0), cB, voffB); PG8_STAGE(PG8_SB(0, 1), cB + hstep, voffB); PG8_STAGE(PG8_SA(0, 0), cA, voffA); PG8_STAGE(PG8_SA(0, 1), cA + hstep, voffA);
        if (wr == 1) PG8_BAR;
        PG8_WAIT_V(2); PG8_BAR;
        PG8_STAGE(PG8_SB(1, 0), cB + kstep, voffB); PG8_STAGE(PG8_SA(1, 0), cA + kstep, voffA); PG8_STAGE(PG8_SB(1, 1), cB + hstep + kstep, voffB);
        PG8_WAIT_V(6); PG8_BAR;
    } else {
        PG8_STAGE(PG8_SB(0, 0), cB, voffB); PG8_STAGE(PG8_SA(0, 0), cA, voffA); PG8_STAGE(PG8_SB(0, 1), cB + hstep, voffB); PG8_STAGE(PG8_SA(0, 1), cA + hstep, voffA);
        if (wr == 1) PG8_BAR;
        PG8_WAIT_V(4); PG8_BAR;
        PG8_STAGE(PG8_SB(1, 0), cB + kstep, voffB); PG8_STAGE(PG8_SA(1, 0), cA + kstep, voffA); PG8_STAGE(PG8_SB(1, 1), cB + hstep + kstep, voffB);
        PG8_WAIT_V(6); PG8_BAR;
    }
    for (;;) {
        const bool has_next = S.next(ui + 1, nxt);
        const char* nA = has_next ? (const char*)g.A + (size_t)nxt.pm * tstep : cA; const char* nB = has_next ? (const char*)g.Bt + (size_t)nxt.pn * tstep : cB;
        for (int t = 0; t < nt; t += 2) {
            const bool last = (t == nt - 2);
            const char* a1 = cA + (size_t)(t + 1) * kstep;
            const char* a2 = last ? nA : cA + (size_t)(t + 2) * kstep; const char* b2 = last ? nB : cB + (size_t)(t + 2) * kstep;
            const char* a3 = a2 + kstep; const char* b3 = b2 + kstep;
            if (last && has_next) S.a_ready(nxt);
            if constexpr (SP2) {
            PG8_LDB(B0, 0, 0); PG8_LDB(B1, 0, 1); PG8_SCHED; PG8_LDA(At, 0, 0); PG8_STAGE(PG8_SA(1, 1), a1 + hstep, voffA);
            PG8_WAIT_V(8); PG8_WAIT_L(0); PG8_BAR; PG8_MMA(0, 0, At, B0); PG8_MMA(0, 1, At, B1); PG8_BAR; PG8_SCHED;
            PG8_LDA(At, 0, 1); PG8_STAGE(PG8_SB(0, 0), b2, voffB); PG8_STAGE(PG8_SB(0, 1), b2 + hstep, voffB); PG8_STAGE(PG8_SA(0, 0), a2, voffA);
            PG8_WAIT_V(8); PG8_WAIT_L(0); PG8_BAR; PG8_MMA(1, 0, At, B0); PG8_MMA(1, 1, At, B1); PG8_BAR; PG8_SCHED;
            PG8_LDB(B0, 1, 0); PG8_LDB(B1, 1, 1); PG8_SCHED; PG8_LDA(At, 1, 0); PG8_STAGE(PG8_SA(0, 1), a2 + hstep, voffA);
            PG8_WAIT_V(8); PG8_WAIT_L(0); PG8_BAR; PG8_MMA(0, 0, At, B0); PG8_MMA(0, 1, At, B1); PG8_BAR; PG8_SCHED;
            PG8_LDA(At, 1, 1); PG8_STAGE(PG8_SB(1, 0), b3, voffB); PG8_STAGE(PG8_SB(1, 1), b3 + hstep, voffB); PG8_STAGE(PG8_SA(1, 0), a3, voffA);
            PG8_WAIT_V(8); PG8_WAIT_L(0); PG8_BAR; PG8_MMA(1, 0, At, B0); PG8_MMA(1, 1, At, B1); PG8_BAR; PG8_SCHED;
            } else {
            PG8_LDB(B0, 0, 0); PG8_SCHED; PG8_LDA(At, 0, 0); PG8_STAGE(PG8_SA(1, 1), a1 + hstep, voffA);
            PG8_WAIT_L(8); PG8_BAR; PG8_WAIT_L(0); PG8_MMA(0, 0, At, B0); PG8_BAR; PG8_SCHED;
            PG8_LDB(B1, 0, 1); PG8_STAGE(PG8_SB(0, 0), b2, voffB);
            PG8_BAR; PG8_WAIT_L(0); PG8_MMA(0, 1, At, B1); PG8_BAR;
            PG8_LDA(At, 0, 1); PG8_STAGE(PG8_SA(0, 0), a2, voffA);
            PG8_BAR; PG8_WAIT_L(0); PG8_MMA(1, 0, At, B0); PG8_BAR; PG8_SCHED;
            PG8_STAGE(PG8_SB(0, 1), b2 + hstep, voffB);
            PG8_WAIT_V(6); PG8_BAR; PG8_MMA(1, 1, At, B1); PG8_BAR;
            PG8_LDB(B0, 1, 0); PG8_SCHED; PG8_LDA(At, 1, 0); PG8_STAGE(PG8_SA(0, 1), a2 + hstep, voffA);
            PG8_WAIT_L(8); PG8_BAR; PG8_WAIT_L(0); PG8_MMA(0, 0, At, B0); PG8_BAR; PG8_SCHED;
            PG8_LDB(B1, 1, 1); PG8_STAGE(PG8_SB(1, 0), b3, voffB);
            PG8_BAR; PG8_WAIT_L(0); PG8_MMA(0, 1, At, B1); PG8_BAR;
            PG8_LDA(At, 1, 1); PG8_STAGE(PG8_SA(1, 0), a3, voffA);
            PG8_BAR; PG8_WAIT_L(0); PG8_MMA(1, 0, At, B0); PG8_BAR; PG8_SCHED;
            PG8_STAGE(PG8_SB(1, 1), b3 + hstep, voffB);
            PG8_WAIT_V(6); PG8_BAR; PG8_MMA(1, 1, At, B1); PG8_BAR;
            }
        }
        if constexpr (ALIGN_EPI) { if (wr == 0) PG8_BAR; }
        if constexpr (!Epi::AFTER_DRAIN) { E(acc, cur, wr, wc, fr, fq); S.done(cur); }
        if (!has_next) break;
#pragma unroll
        for (int a = 0; a < 2; ++a)
#pragma unroll
            for (int b = 0; b < 2; ++b)
#pragma unroll
                for (int m = 0; m < 4; ++m)
#pragma unroll
                    for (int n = 0; n < 2; ++n) acc[a][b][m][n] = (f32x4){0.f, 0.f, 0.f, 0.f};
        cur = nxt; cA = nA; cB = nB; ++ui;
        if constexpr (ALIGN_EPI) { if (wr == 1) PG8_BAR; }
    }
    PG8_WAIT_V(0);
    if constexpr (!ALIGN_EPI) { if (wr == 0) PG8_BAR; }
    PG8_BAR;
    if constexpr (Epi::AFTER_DRAIN) { E.fused(acc, cur, wr, wc, fr, fq, lds, wid, lane); S.done(cur); }
#undef PG8_SA
#undef PG8_SB
#undef PG8_STAGE
#undef PG8_LDA
#undef PG8_LDB
#undef PG8_MMA
#undef PG8_WAIT_V
#undef PG8_WAIT_L
#undef PG8_BAR
#undef PG8_SCHED
}
}

#define LAS __attribute__((address_space(3)))
typedef unsigned short bf16;
typedef short bf16x8 __attribute__((ext_vector_type(8)));
typedef float f32x4 __attribute__((ext_vector_type(4)));
typedef unsigned u32x4 __attribute__((ext_vector_type(4)));
typedef unsigned u32x2 __attribute__((ext_vector_type(2)));

constexpr int NB = 4, NT = 2048, NM = NB * NT, ND = 2048, DIN = 6930, NPAD = 7168, DFF = 5632, NL = 4;
constexpr int HD_AQ = 0, HD_AK = 4, HD_BF = 12, HD_BQ = 18, HD_BI = 24, HD_BG = 30, HD_CQ = 36, HD_CKC = 42, HD_CKS = 46, HD_CKW = 50;
constexpr size_t HDSZ = (size_t)NM * 128;
constexpr float EPS = 1e-6f;
constexpr float LOG2E = 1.4426950408889634f;
#ifndef PROBE_CMP
#define PROBE_CMP 1.f
#endif
#ifndef PROBE_SEL
#define PROBE_SEL 1.f
#endif
#ifndef PROBE_WIN
#define PROBE_WIN 1.f
#endif

constexpr size_t MiB = 1u << 20;
constexpr size_t WS_CTL = 0, CTL_ZERO_BYTES = 1 * MiB;
constexpr size_t WS_SMALL = 1 * MiB;
constexpr size_t WS_W = 2 * MiB;
constexpr size_t WL_IN = 0, WL_OUT = 28 * MiB, WL_GU = 36 * MiB, WL_DN = 80 * MiB, WL_C1 = 102 * MiB, WL_W2 = 106 * MiB, WL_SZ = 107 * MiB;
constexpr size_t WS_XA = WS_W + NL * WL_SZ;
constexpr size_t WS_HN = WS_XA + 32 * MiB;
constexpr size_t WS_P = WS_HN + 32 * MiB;
constexpr size_t WS_LF = WS_P + 108 * MiB;
constexpr size_t WS_HF = WS_P;
constexpr size_t WS_GT = WS_LF + 24 * MiB;
constexpr size_t WS_VT = WS_GT + 1 * MiB;
constexpr size_t WS_Y = WS_VT + 16 * MiB;
constexpr size_t WS_YW = WS_Y + 32 * MiB;
constexpr size_t WS_YCM = WS_YW + 24 * MiB;
constexpr size_t WS_HC = WS_YCM + 24 * MiB;
constexpr size_t WS_KC = WS_HC + 4 * MiB;
constexpr size_t WS_SELM = WS_KC + 1 * MiB;
constexpr size_t WS_DS = WS_SELM + 1 * MiB;
constexpr size_t WS_DEC = WS_DS + 48 * MiB;
constexpr size_t WS_SP = WS_DEC + 1 * MiB;
constexpr size_t WS_SSP = WS_SP + 24 * MiB;
constexpr size_t WS_END = WS_SSP + 3 * MiB;
static_assert(WS_HF + 88 * MiB <= WS_GT, "HF overlay");
constexpr int CW_BAR = 4096;
constexpr int CW_Q = 16384;

constexpr int LDS_BYTES = 147456;
constexpr int MISC_OFF = 147456 - 256;

__device__ __forceinline__ unsigned f2bf(float f) { return (unsigned)__builtin_bit_cast(unsigned short, (__bf16)f); }
__device__ __forceinline__ unsigned pk2(float lo, float hi) { return pg8::cvt_pk_bf16(lo, hi); }
__device__ __forceinline__ float bf2f(unsigned short b) { return __builtin_bit_cast(float, (unsigned)b << 16); }
__device__ __forceinline__ float wave_sum(float v) {
#pragma unroll
    for (int o = 1; o < 64; o <<= 1) v += __shfl_xor(v, o);
    return v;
}
__device__ __forceinline__ float row16_sum(float v) {
    v += __builtin_bit_cast(float, __builtin_amdgcn_update_dpp(0, __builtin_bit_cast(int, v), 0xB1, 0xF, 0xF, true));
    v += __builtin_bit_cast(float, __builtin_amdgcn_update_dpp(0, __builtin_bit_cast(int, v), 0x4E, 0xF, 0xF, true));
    v += __builtin_bit_cast(float, __builtin_amdgcn_update_dpp(0, __builtin_bit_cast(int, v), 0x141, 0xF, 0xF, true));
    v += __builtin_bit_cast(float, __builtin_amdgcn_update_dpp(0, __builtin_bit_cast(int, v), 0x140, 0xF, 0xF, true));
    return v;
}
__device__ __forceinline__ float row16_max(float v) {
    v = fmaxf(v, __builtin_bit_cast(float, __builtin_amdgcn_update_dpp(0, __builtin_bit_cast(int, v), 0xB1, 0xF, 0xF, true)));
    v = fmaxf(v, __builtin_bit_cast(float, __builtin_amdgcn_update_dpp(0, __builtin_bit_cast(int, v), 0x4E, 0xF, 0xF, true)));
    v = fmaxf(v, __builtin_bit_cast(float, __builtin_amdgcn_update_dpp(0, __builtin_bit_cast(int, v), 0x141, 0xF, 0xF, true)));
    v = fmaxf(v, __builtin_bit_cast(float, __builtin_amdgcn_update_dpp(0, __builtin_bit_cast(int, v), 0x140, 0xF, 0xF, true)));
    return v;
}
#define LDS_WAIT() asm volatile("s_waitcnt lgkmcnt(0)" ::: "memory")
#define LDS_BARRIER() do { asm volatile("s_waitcnt lgkmcnt(0)" ::: "memory"); __builtin_amdgcn_s_barrier(); asm volatile("" ::: "memory"); } while (0)
#define VM_WAIT() asm volatile("s_waitcnt vmcnt(0)" ::: "memory")
__device__ __forceinline__ unsigned cvt_pk_nop(float lo, float hi) { return pg8::cvt_pk_bf16(lo, hi); }
__device__ __forceinline__ f32x4 mfma16(bf16x8 a, bf16x8 b, f32x4 c) { return __builtin_amdgcn_mfma_f32_16x16x32_bf16(a, b, c, 0, 0, 0); }

#define XB_TMO      128
#define XB_XCNT(j)  (256  + 64 * (j))
#define XB_XSUB(j)  (1280 + 64 * (j))
#define XB_XGEN(j)  (2304 + 64 * (j))
#define XB_TOP      3328
#define XB_TOPGEN   3392
#define XCD_BAR_WORDS 3456
#define XB_SPIN_CAP (1u << 22)
__device__ __forceinline__ unsigned xb_ld(unsigned* p)              { return __hip_atomic_load(p, __ATOMIC_RELAXED, __HIP_MEMORY_SCOPE_AGENT); }
__device__ __forceinline__ unsigned xb_add(unsigned* p, unsigned v) { return __hip_atomic_fetch_add(p, v, __ATOMIC_RELAXED, __HIP_MEMORY_SCOPE_AGENT); }
__device__ __forceinline__ unsigned xb_xcc_id() { return (unsigned)__builtin_amdgcn_s_getreg((3 << 11) | 20) & 0xFu; }
#define XB_SPIN(cond, bar) do { unsigned _sp = 0; while (cond) { __builtin_amdgcn_s_sleep(1); \
    if ((++_sp & 255u) == 0u) { if (xb_ld(&(bar)[XB_TMO])) break; if (_sp > XB_SPIN_CAP) { atomicAdd(&(bar)[XB_TMO], 1u); break; } } } } while (0)
struct XcdBarrier { unsigned* bar; unsigned x; volatile LAS unsigned* st; };
__device__ __forceinline__ XcdBarrier xcd_barrier_post(unsigned* bar, volatile LAS unsigned* st) {
    XcdBarrier b; b.bar = bar; b.x = xb_xcc_id(); b.st = st;
    if (threadIdx.x == 0) (void)xb_add(&bar[XB_XCNT(b.x)], 1u);
    return b;
}
__device__ __forceinline__ void xcd_barrier_complete(unsigned* bar, unsigned x, unsigned& nloc, unsigned& nx) {
    const unsigned G = gridDim.x * gridDim.y * gridDim.z;
    unsigned sum, cnt, mine, sp = 0u;
    for (;;) {
        sum = 0u; cnt = 0u; mine = 0u;
#pragma unroll
        for (unsigned j = 0; j < 16; ++j) { const unsigned c = xb_ld(&bar[XB_XCNT(j)]); sum += c; cnt += (c > 0u) ? 1u : 0u; mine = (j == x) ? c : mine; }
        if (sum == G) break;
        __builtin_amdgcn_s_sleep(1);
        if ((++sp & 255u) == 0u) { if (xb_ld(&bar[XB_TMO])) break; if (sp > XB_SPIN_CAP) { atomicAdd(&bar[XB_TMO], 1u); break; } }
    }
    nloc = mine > 0u ? mine : 1u; nx = cnt > 0u ? cnt : 1u;
}
__device__ __forceinline__ void xcd_barrier(const XcdBarrier& b) {
    asm volatile("s_waitcnt vmcnt(0)" ::: "memory");
    __syncthreads();
    if (threadIdx.x == 0) {
        unsigned* bar = b.bar;
        __builtin_amdgcn_s_waitcnt(0);
        unsigned nloc = b.st[0], nx = b.st[1];
        if (nloc == 0u) { xcd_barrier_complete(bar, b.x, nloc, nx); b.st[0] = nloc; b.st[1] = nx; }
        const unsigned old = xb_add(&bar[XB_XSUB(b.x)], 1u);
        const unsigned gen = old / nloc;
        if (old + 1u == (gen + 1u) * nloc) {
            __builtin_amdgcn_fence(__ATOMIC_RELEASE, "agent");
            asm volatile("s_waitcnt vmcnt(0)" ::: "memory");
            const unsigned og = xb_add(&bar[XB_TOP], 1u);
            const unsigned tg = og / nx;
            if (og + 1u == (tg + 1u) * nx) xb_add(&bar[XB_TOPGEN], 1u);
            else XB_SPIN(xb_ld(&bar[XB_TOPGEN]) == tg, bar);
            __builtin_amdgcn_fence(__ATOMIC_ACQUIRE, "agent");
            xb_add(&bar[XB_XGEN(b.x)], 1u);
            asm volatile("s_waitcnt vmcnt(0)" ::: "memory");
        } else {
            XB_SPIN(xb_ld(&bar[XB_XGEN(b.x)]) == gen, bar);
            __builtin_amdgcn_fence(__ATOMIC_ACQUIRE, "agent");
            asm volatile("s_waitcnt vmcnt(0)" ::: "memory");
        }
    }
    __syncthreads();
}

struct Params {
    const float* x; const float* attn_norm; const float* w_in; const float* lq1; const float* lk1; const float* lq2; const float* lk2; const float* da_norm;
    const float* hg_gamma; const float* hg_norm; const float* pe_k; const float* pe_v; const float* ck_w1; const float* ck_w2; const float* cv_w1; const float* cv_w2;
    const float* w_out; const float* ffn_norm; const float* w_gate; const float* w_up; const float* w_down; const float* final_norm;
    float* out; unsigned char* ws; int ph_lo, ph_hi;
};
struct Ctx { LAS unsigned char* lds; int tid, lane, wave, bid, G; unsigned* ctl; };

__device__ __forceinline__ int q_next(const Ctx& C, unsigned* qbase  , int N, int& sub  ) {
    volatile LAS int* slot = (volatile LAS int*)(C.lds + MISC_OFF + 16);
    LDS_BARRIER();
    if (C.tid == 0) {
        int x = sub < 0 ? (C.bid & 7) : sub, it = N;
        for (int tries = 0; tries < 8; ++tries) {
            const int k = (int)__hip_atomic_fetch_add(qbase + 64 * x, 1u, __ATOMIC_RELAXED, __HIP_MEMORY_SCOPE_AGENT);
            if (8 * k + x < N) { it = 8 * k + x; break; }
            if (C.G >= 8 && (C.G & 7) == 0) break;
            x = (x + 1) & 7; }
        slot[0] = it; slot[1] = x; }
    LDS_BARRIER();
    sub = slot[1];
    return slot[0];
}

struct CvDesc { const float* W; bf16* WT; const float* gain; int ldw, nvalid, k0, n0, ldt, orow0; };
constexpr int IT_IN = 16 * 112, IT_OUT = 16 * 32, IT_G = 16 * 88, IT_DN = 44 * 32, IT_C1 = 16 * 4, IT_W2 = 2 * 2;
constexpr int IT_LAYER = IT_IN + IT_OUT + 2 * IT_G + IT_DN + 4 * IT_C1 + 2 * IT_W2;
constexpr int CV_TILE = 64 * 65;
static_assert(4096 + 8 * CV_TILE * 4 <= MISC_OFF, "conversion tiles");
__device__ __forceinline__ void cv_decode(const Params& p, int it, CvDesc& d) {
    const int l = it / IT_LAYER; int r = it - l * IT_LAYER;
    unsigned char* wl = p.ws + WS_W + (size_t)l * WL_SZ;
    d.gain = nullptr;
    if (r < IT_IN) { const int kb = r / 112, nb = r % 112; d.W = p.w_in + (size_t)l * ND * DIN; d.ldw = DIN; d.nvalid = DIN; d.k0 = kb * 128; d.n0 = nb * 64; d.WT = (bf16*)(wl + WL_IN); d.ldt = ND; d.orow0 = nb * 64; d.gain = p.attn_norm + (size_t)l * ND; return; } r -= IT_IN;
    if (r < IT_OUT) { const int kb = r / 32, nb = r % 32; d.W = p.w_out + (size_t)l * ND * ND; d.ldw = ND; d.nvalid = ND; d.k0 = kb * 128; d.n0 = nb * 64; d.WT = (bf16*)(wl + WL_OUT); d.ldt = ND; d.orow0 = nb * 64; return; } r -= IT_OUT;
    if (r < 2 * IT_G) { const int up = r >= IT_G; if (up) r -= IT_G; const int kb = r / 88, nb = r % 88, n0 = nb * 64; d.W = (up ? p.w_up : p.w_gate) + (size_t)l * ND * DFF; d.ldw = DFF; d.nvalid = DFF; d.k0 = kb * 128; d.n0 = n0;
        d.WT = (bf16*)(wl + WL_GU); d.ldt = ND; d.orow0 = 256 * (n0 >> 7) + 128 * up + (n0 & 127); d.gain = p.ffn_norm + (size_t)l * ND; return; } r -= 2 * IT_G;
    if (r < IT_DN) { const int kb = r / 32, nb = r % 32; d.W = p.w_down + (size_t)l * DFF * ND; d.ldw = ND; d.nvalid = ND; d.k0 = kb * 128; d.n0 = nb * 64; d.WT = (bf16*)(wl + WL_DN); d.ldt = DFF; d.orow0 = nb * 64; return; } r -= IT_DN;
    if (r < 4 * IT_C1) { const int q = r / IT_C1, rr = r % IT_C1, kb = rr / 4, nb = rr % 4, kv = q >> 1, half = q & 1;
        d.W = (kv ? p.cv_w1 : p.ck_w1) + (size_t)l * 4096 * 256 + (size_t)half * 2048 * 256; d.ldw = 256; d.nvalid = 256; d.k0 = kb * 128; d.n0 = nb * 64;
        d.WT = (bf16*)(wl + WL_C1) + (size_t)kv * 512 * 2048; d.ldt = 2048; d.orow0 = half * 256 + nb * 64; return; } r -= 4 * IT_C1;
    { const int kv = r / IT_W2, rr = r % IT_W2, kb = rr / 2, nb = rr % 2;
        d.W = (kv ? p.cv_w2 : p.ck_w2) + (size_t)l * 256 * 128; d.ldw = 128; d.nvalid = 128; d.k0 = kb * 128; d.n0 = nb * 64; d.WT = (bf16*)(wl + WL_W2) + (size_t)kv * 128 * 256; d.ldt = 256; d.orow0 = nb * 64; }
}
__device__ __forceinline__ void cv_load(const CvDesc& d, int hb, int lane, float (&t)[32]) {
    const int n = d.n0 + lane;
    const float* wp = d.W + (size_t)(d.k0 + hb) * d.ldw + (n < d.nvalid ? n : 0);
#pragma unroll
    for (int i = 0; i < 32; ++i) t[i] = wp[(size_t)i * d.ldw];
}
__device__ __forceinline__ void cv_put(const CvDesc& d, int hb, int lane, LAS unsigned* scr, const float (&t)[32]) {
    const bool ok = d.n0 + lane < d.nvalid;
#pragma unroll
    for (int i = 0; i < 16; ++i) { float v0 = ok ? t[2 * i] : 0.f, v1 = ok ? t[2 * i + 1] : 0.f; if (d.gain) { v0 *= d.gain[d.k0 + hb + 2 * i]; v1 *= d.gain[d.k0 + hb + 2 * i + 1]; }
        scr[((hb >> 1) + i) * 65 + lane] = pk2(v0, v1); }
}
__device__ __forceinline__ void cv_out(const CvDesc& d, int lane, const LAS unsigned* scr) {
    LDS_WAIT(); asm volatile("" ::: "memory");
    const int c = lane & 15;
#pragma unroll
    for (int j = 0; j < 16; ++j) { const int nn = (lane >> 4) + 4 * j; const LAS unsigned* s = scr + (4 * c) * 65 + nn;
        u32x4 o; o.x = s[0]; o.y = s[65]; o.z = s[130]; o.w = s[195];
        *(u32x4*)(d.WT + (size_t)(d.orow0 + nn) * d.ldt + d.k0 + 8 * c) = o; }
    LDS_WAIT(); asm volatile("" ::: "memory");
}
__device__ __forceinline__ void p0_prologue(const Ctx& C, const Params& p) {
    unsigned char* ws = p.ws;
    float* small = (float*)(ws + WS_SMALL);
    {
        const int q8 = C.bid >> 5, sl = C.bid & 31, l = q8 >> 1, kv = q8 & 1, c = C.tid & 255, half = C.tid >> 8;
        if (q8 < 8) {
        const float* pe = (kv ? p.pe_v : p.pe_k) + (size_t)l * 4096; const float* w1 = (kv ? p.cv_w1 : p.ck_w1) + (size_t)l * 4096 * 256;
        float a = 0.f;
#pragma unroll 16
        for (int r = sl * 128 + half * 64; r < sl * 128 + half * 64 + 64; ++r) a += pe[r] * w1[(size_t)r * 256 + c];
        LAS float* red = (LAS float*)C.lds;
        if (half == 1) red[c] = a;
        __syncthreads();
        if (half == 0) small[8192 + (q8 * 32 + sl) * 256 + c] = a + red[c];
        __syncthreads(); }
    }
    if (C.bid == 8) {

        for (int c = C.tid; c < 768; c += 512) {
            float g[NL], mx = -1e30f; for (int l = 0; l < NL; ++l) { g[l] = p.hg_gamma[l * 768 + c]; mx = fmaxf(mx, g[l]); }
            float s = 0.f; for (int l = 0; l < NL; ++l) { g[l] = __expf(g[l] - mx); s += g[l]; }
            float cum = 0.f, first = g[0] / s;
            for (int l = 0; l < NL; ++l) { cum += g[l] / s; small[4 + l * 768 + c] = cum - first; }
        }
        if (C.tid < NL) { const int l = C.tid; float s1 = 0.f, s2 = 0.f;
            for (int i = 0; i < 64; ++i) { s1 += p.lq1[l * 64 + i] * p.lk1[l * 64 + i]; s2 += p.lq2[l * 64 + i] * p.lk2[l * 64 + i]; }
            small[l] = expf(s1) - expf(s2) + (0.8f - 0.6f * expf(-0.3f * (float)l)); }
    }
    { const int gw_ = C.bid * 8 + C.wave, NGW_ = C.G * 8; bf16* HN = (bf16*)(ws + WS_HN); float* SS = (float*)(ws + WS_SSP);
      for (int row = gw_; row < NM; row += NGW_) { const float* xr = p.x + (size_t)row * ND + C.lane * 4; float q = 0.f;
#pragma unroll
          for (int j = 0; j < 8; ++j) { const f32x4 v = *(const f32x4*)(xr + j * 256); q += (v[0] * v[0] + v[1] * v[1]) + (v[2] * v[2] + v[3] * v[3]);
              u32x2 w; w.x = pk2(v[0], v[1]); w.y = pk2(v[2], v[3]); *(u32x2*)(HN + (size_t)row * ND + j * 256 + C.lane * 4) = w; }
          q = wave_sum(q); if (C.lane < 8) SS[(size_t)row * 8 + C.lane] = C.lane == 0 ? q : 0.f; } }
    LAS unsigned* scr = (LAS unsigned*)(C.lds + 4096) + C.wave * CV_TILE;
    const int gw = C.bid * 8 + C.wave, NGW = C.G * 8;
    if (gw < NL * IT_LAYER) {
        CvDesc d; float ta[32], tb[32];
        cv_decode(p, gw, d); cv_load(d, 0, C.lane, ta);
#pragma unroll 1
        for (int it = gw; it < NL * IT_LAYER; it += NGW) {
            cv_load(d, 32, C.lane, tb); cv_put(d, 0, C.lane, scr, ta);
            cv_load(d, 64, C.lane, ta); cv_put(d, 32, C.lane, scr, tb);
            cv_load(d, 96, C.lane, tb); cv_put(d, 64, C.lane, scr, ta);
            CvDesc dn = d; const bool more = it + NGW < NL * IT_LAYER;
            if (more) { cv_decode(p, it + NGW, dn); cv_load(dn, 0, C.lane, ta); }
            cv_put(d, 96, C.lane, scr, tb);
            cv_out(d, C.lane, scr);
            d = dn; }
    }
}

__device__ __forceinline__ void norm_rows(const Ctx& C, const float* src, const float* gain, bf16* dst_bf, float* dst_f) {
    const int gw = C.bid * 8 + C.wave, NGW = C.G * 8;
    for (int row = gw; row < NM; row += NGW) {
        const float* xr = src + (size_t)row * ND + C.lane * 4;
        f32x4 v[8]; float ss = 0.f;
#pragma unroll
        for (int j = 0; j < 8; ++j) { v[j] = *(const f32x4*)(xr + j * 256); ss += (v[j][0] * v[j][0] + v[j][1] * v[j][1]) + (v[j][2] * v[j][2] + v[j][3] * v[j][3]); }
        const float r = rsqrtf(wave_sum(ss) * (1.f / ND) + EPS);
#pragma unroll
        for (int j = 0; j < 8; ++j) { const f32x4 g = *(const f32x4*)(gain + j * 256 + C.lane * 4); const f32x4 y = v[j] * r * g;
            if (dst_bf) { u32x2 w; w.x = pk2(y[0], y[1]); w.y = pk2(y[2], y[3]); *(u32x2*)(dst_bf + (size_t)row * ND + j * 256 + C.lane * 4) = w; }
            else *(f32x4*)(dst_f + (size_t)row * ND + j * 256 + C.lane * 4) = y; }
    }
}

__device__ __forceinline__ void final_norm_rows(const Ctx& C, const bf16* src, const float* gain, float* dst) {
    const int gw = C.bid * 8 + C.wave, NGW = C.G * 8;
    for (int rowg = gw; rowg < NM; rowg += 4 * NGW) {
        u32x4 h[4][4];
#pragma unroll
        for (int q = 0; q < 4; ++q) { const int row = rowg + q * NGW; const bf16* xr = src + (size_t)(row < NM ? row : rowg) * ND + C.lane * 8;
#pragma unroll
            for (int j = 0; j < 4; ++j) h[q][j] = *(const u32x4*)(xr + j * 512); }
#pragma unroll
        for (int q = 0; q < 4; ++q) { const int row = rowg + q * NGW;
            f32x4 v[8]; float ss = 0.f;
#pragma unroll
            for (int j = 0; j < 4; ++j) { const u32x4 hh = h[q][j];
                v[2 * j] = (f32x4){__builtin_bit_cast(float, hh.x << 16), __builtin_bit_cast(float, hh.x & 0xffff0000u), __builtin_bit_cast(float, hh.y << 16), __builtin_bit_cast(float, hh.y & 0xffff0000u)};
                v[2 * j + 1] = (f32x4){__builtin_bit_cast(float, hh.z << 16), __builtin_bit_cast(float, hh.z & 0xffff0000u), __builtin_bit_cast(float, hh.w << 16), __builtin_bit_cast(float, hh.w & 0xffff0000u)}; }
#pragma unroll
            for (int j = 0; j < 8; ++j) ss += (v[j][0] * v[j][0] + v[j][1] * v[j][1]) + (v[j][2] * v[j][2] + v[j][3] * v[j][3]);
            const float r = rsqrtf(wave_sum(ss) * (1.f / ND) + EPS);
            if (row < NM) {
#pragma unroll
                for (int j = 0; j < 4; ++j) { const float* gp = gain + j * 512 + C.lane * 8; float* dp = dst + (size_t)row * ND + j * 512 + C.lane * 8;
                    *(f32x4*)dp = v[2 * j] * r * *(const f32x4*)gp; *(f32x4*)(dp + 4) = v[2 * j + 1] * r * *(const f32x4*)(gp + 4); } } }
    }
}

constexpr int AT_K_BYTES = 64 * 256, AT_V_BYTES = 128 * 128;
constexpr int AT_K_OFF = 0, AT_V_OFF = 2 * AT_K_BYTES, AT_END = AT_V_OFF + 2 * AT_V_BYTES;
constexpr int AT_X_BYTES = 128 * 32 * 4 + 256;
static_assert(AT_END <= MISC_OFF && 6 * AT_X_BYTES <= MISC_OFF, "attention LDS");
enum { MODE_DIFF = 0, MODE_WIN = 1, MODE_SEL = 2 };

struct AttnOut { f32x4 o[2][8]; float l[2]; float m[2]; };
__device__ __forceinline__ float qmax4(float v) {
    const auto a = __builtin_amdgcn_permlane32_swap(__float_as_uint(v), __float_as_uint(v), false, false);
    v = fmaxf(__uint_as_float(a[0]), __uint_as_float(a[1]));
    const auto b = __builtin_amdgcn_permlane16_swap(__float_as_uint(v), __float_as_uint(v), false, false);
    return fmaxf(__uint_as_float(b[0]), __uint_as_float(b[1]));
}
__device__ __forceinline__ float qsum4(float v) {
    const auto a = __builtin_amdgcn_permlane32_swap(__float_as_uint(v), __float_as_uint(v), false, false);
    v = __uint_as_float(a[0]) + __uint_as_float(a[1]);
    const auto b = __builtin_amdgcn_permlane16_swap(__float_as_uint(v), __float_as_uint(v), false, false);
    return __uint_as_float(b[0]) + __uint_as_float(b[1]);
}

template <int MODE, int NKT  >
__device__ __forceinline__ void attn_core(const Ctx& C, const bf16* Qw  , const bf16* Kp  , const bf16* VTp  ,
                                          int doff, int gk, int wq0  , int j_lo, int j_hi, const unsigned* selm  , float c2, AttnOut& R) {
    constexpr int NKS = (MODE == MODE_DIFF) ? 2 : 4;
    const int lane = C.lane, lr = lane & 15, lq = lane >> 4, tid = C.tid;
    LAS unsigned char* lds = C.lds;
    bf16x8 qf[2][NKS];
#pragma unroll
    for (int rt = 0; rt < 2; ++rt)
#pragma unroll
        for (int ks = 0; ks < NKS; ++ks) qf[rt][ks] = *(const bf16x8*)(Qw + (size_t)(rt * 16 + lr) * 128 + ks * 32 + 8 * lq);
    unsigned sm[2] = {0xffffffffu, 0xffffffffu}; unsigned wor = 0xffffffffu, wandu = 0xffffffffu;
    if (MODE == MODE_SEL) { sm[0] = selm[wq0 + lr]; sm[1] = selm[wq0 + 16 + lr]; wor = sm[0] | sm[1]; wandu = sm[0] & sm[1];
        {
#define AT_RED(ctl) do { wor |= (unsigned)__builtin_amdgcn_update_dpp(0, (int)wor, ctl, 0xF, 0xF, true); wandu &= (unsigned)__builtin_amdgcn_update_dpp(0, (int)wandu, ctl, 0xF, 0xF, true); } while (0)
            AT_RED(0xB1); AT_RED(0x4E); AT_RED(0x141); AT_RED(0x140);
#undef AT_RED
        }
        wor = __builtin_amdgcn_readfirstlane(wor); wandu = __builtin_amdgcn_readfirstlane(wandu); }
#pragma unroll
    for (int rt = 0; rt < 2; ++rt) { R.m[rt] = 0.f; R.l[rt] = 0.f;
#pragma unroll
        for (int vt = 0; vt < 8; ++vt) R.o[rt][vt] = (f32x4){0.f, 0.f, 0.f, 0.f}; }
    f32x4 negm[2] = {(f32x4){0.f, 0.f, 0.f, 0.f}, (f32x4){0.f, 0.f, 0.f, 0.f}}, lacc[2] = {(f32x4){0.f, 0.f, 0.f, 0.f}, (f32x4){0.f, 0.f, 0.f, 0.f}};
    bool seen[2] = {false, false}; bool unseen_any = true;
    const bf16x8 ones = (bf16x8){(short)0x3F80, (short)0x3F80, (short)0x3F80, (short)0x3F80, (short)0x3F80, (short)0x3F80, (short)0x3F80, (short)0x3F80};
#define AT_DMA(j, buf) do { const int kb_ = (j) * 64; \
        _Pragma("unroll") for (int i_ = 0; i_ < 2; ++i_) { const int q_ = C.wave + 8 * i_; \
            const int kr_ = 4 * q_ + (lane >> 4), kc_ = (lane & 15) ^ (kr_ & 15); \
            const int kk_ = 32 * (kr_ >> 5) + 8 * ((kr_ >> 2) & 3) + 4 * ((kr_ >> 4) & 1) + (kr_ & 3);     \
            __builtin_amdgcn_global_load_lds((const unsigned*)(Kp + (size_t)(kb_ + kk_) * 128 + kc_ * 8), (LAS unsigned*)(lds + AT_K_OFF + (buf) * AT_K_BYTES + q_ * 1024), 16, 0, 0); \
            const int vr_ = 8 * q_ + (lane >> 3), vc_ = (lane & 7) ^ ((vr_ >> 1) & 7); \
            __builtin_amdgcn_global_load_lds((const unsigned*)(VTp + (size_t)vr_ * 2048 + kb_ + vc_ * 8), (LAS unsigned*)(lds + AT_V_OFF + (buf) * AT_V_BYTES + q_ * 1024), 16, 0, 0); } } while (0)
    AT_DMA(j_lo, 0);
    for (int j = j_lo; j < j_hi; ++j) {
        const int buf = (j - j_lo) & 1;
        asm volatile("s_waitcnt vmcnt(0)" ::: "memory"); __builtin_amdgcn_s_barrier(); asm volatile("" ::: "memory");
        bf16x8 kf[NKS][NKT];
        { const LAS unsigned char* kl0 = lds + AT_K_OFF + buf * AT_K_BYTES + (32 * gk) * 256;
#pragma unroll
          for (int ks = 0; ks < NKS; ++ks)
#pragma unroll
            for (int kt = 0; kt < NKT; ++kt) kf[ks][kt] = *(const LAS bf16x8*)(kl0 + (kt * 16 + lr) * 256 + ((((doff >> 3) + 4 * ks + lq) ^ lr) << 4)); }
        __builtin_amdgcn_sched_barrier(0);
        if (j + 1 < j_hi) AT_DMA(j + 1, buf ^ 1);
        const int kb = j * 64 + 32 * gk;
        bool act = (kb <= wq0 + 31);
        if (MODE == MODE_WIN) act = act && (kb + 16 * NKT - 1 >= wq0 - 511);
        if (MODE == MODE_SEL) act = act && ((wor >> j) & 1u);
        if (act) {
            const LAS unsigned char* kl = lds + AT_K_OFF + buf * AT_K_BYTES + (32 * gk) * 256; const LAS unsigned char* vl = lds + AT_V_OFF + buf * AT_V_BYTES;
            f32x4 s[NKT][2];
#pragma unroll
            for (int kt = 0; kt < NKT; ++kt) { s[kt][0] = negm[0]; s[kt][1] = negm[1]; }
            u32x4 vw[8];
#pragma unroll
            for (int vt = 0; vt < 8; ++vt) { const int c_ = 4 * gk + lq, s_ = (lr >> 1) & 7; vw[vt] = *(const LAS u32x4*)(vl + (vt * 16 + lr) * 128 + ((c_ ^ s_) << 4)); }
            __builtin_amdgcn_sched_barrier(0);
            bool needmask = (kb + 16 * NKT - 1 > wq0);
            if (MODE == MODE_WIN) needmask = needmask || (kb <= wq0 + 31 - 512 + 1);
            if (MODE == MODE_SEL) needmask = needmask || !((wandu >> j) & 1u);
            bool selonly = false;
            if (MODE == MODE_SEL) selonly = needmask && !(kb + 16 * NKT - 1 > wq0);
            u32x4 pb[2][NKT / 2];
            float alpha_s[2] = {1.f, 1.f};
#define AT_MASK(rt) do { if (selonly) { const bool rowok_ = (sm[rt] >> j) & 1u; \
                    _Pragma("unroll") for (int kt = 0; kt < NKT; ++kt) _Pragma("unroll") for (int r = 0; r < 4; ++r) s[kt][rt][r] = rowok_ ? s[kt][rt][r] : -__builtin_inff(); } \
                else if (needmask) { const int pos_ = wq0 + (rt) * 16 + lr; bool rowok_ = true; if (MODE == MODE_SEL) rowok_ = (sm[rt] >> j) & 1u; \
                    _Pragma("unroll") for (int kt = 0; kt < NKT; ++kt) _Pragma("unroll") for (int r = 0; r < 4; ++r) { const int key_ = kb + 32 * (kt >> 1) + 8 * lq + 4 * (kt & 1) + r; bool ok_ = rowok_ && key_ <= pos_; \
                        if (MODE == MODE_WIN) ok_ = ok_ && (pos_ - key_ < 512); if (!ok_) s[kt][rt][r] = -__builtin_inff(); } } } while (0)
#define AT_REF(rt) do { int hot_ = 0x80000000; \
                _Pragma("unroll") for (int kt = 0; kt < NKT; ++kt) { hot_ = max(max(hot_, __float_as_int(s[kt][rt][0])), __float_as_int(s[kt][rt][1])); hot_ = max(max(hot_, __float_as_int(s[kt][rt][2])), __float_as_int(s[kt][rt][3])); } \
                if (unseen_any || __any(hot_ > 0x41000000)) { \
                    float mx_ = fmaxf(fmaxf(s[0][rt][0], s[0][rt][1]), fmaxf(s[0][rt][2], s[0][rt][3])); \
                    _Pragma("unroll") for (int kt = 1; kt < NKT; ++kt) mx_ = fmaxf(mx_, fmaxf(fmaxf(s[kt][rt][0], s[kt][rt][1]), fmaxf(s[kt][rt][2], s[kt][rt][3]))); \
                    mx_ = qmax4(mx_); \
                    const bool valid_ = mx_ > -__builtin_inff(); \
                    const float delta_ = (valid_ && (mx_ > 8.f || !seen[rt])) ? mx_ : 0.f; \
                    alpha_s[rt] = seen[rt] ? __builtin_amdgcn_exp2f(-delta_) : (delta_ != 0.f ? 0.f : 1.f); \
                    seen[rt] = seen[rt] || valid_; \
                    R.m[rt] += delta_; negm[rt] = (f32x4){-R.m[rt], -R.m[rt], -R.m[rt], -R.m[rt]}; \
                    _Pragma("unroll") for (int kt = 0; kt < NKT; ++kt) s[kt][rt] = s[kt][rt] - delta_; \
                    if (__any(alpha_s[rt] != 1.f)) { lacc[rt] *= alpha_s[rt]; _Pragma("unroll") for (int vt = 0; vt < 8; ++vt) R.o[rt][vt] *= alpha_s[rt]; } } } while (0)
#define AT_ES(rt, i) do { if (NKT == 4) { const int kt_ = (i) >> 1, r0_ = 2 * ((i) & 1); s[kt_][rt][r0_] = __builtin_amdgcn_exp2f(s[kt_][rt][r0_]); s[kt_][rt][r0_ + 1] = __builtin_amdgcn_exp2f(s[kt_][rt][r0_ + 1]); \
                    pb[rt][kt_ >> 1][2 * (kt_ & 1) + ((i) & 1)] = cvt_pk_nop(s[kt_][rt][r0_], s[kt_][rt][r0_ + 1]); } \
                else { const int kt_ = (i) >> 2, r_ = (i) & 3; s[kt_][rt][r_] = __builtin_amdgcn_exp2f(s[kt_][rt][r_]); \
                    if (r_ & 1) pb[rt][0][2 * kt_ + (r_ >> 1)] = cvt_pk_nop(s[kt_][rt][r_ - 1], s[kt_][rt][r_]); } } while (0)
#pragma unroll
            for (int ks = 0; ks < NKS; ++ks)
#pragma unroll
                for (int kt = 0; kt < NKT; ++kt) s[kt][0] = mfma16(kf[ks][kt], qf[0][ks], s[kt][0]);
            AT_MASK(0);
            AT_REF(0);
            __builtin_amdgcn_sched_barrier(0);
#pragma unroll
            for (int ks = 0; ks < NKS; ++ks)
#pragma unroll
                for (int kt = 0; kt < NKT; ++kt) { s[kt][1] = mfma16(kf[ks][kt], qf[1][ks], s[kt][1]); AT_ES(0, ks * NKT + kt); __builtin_amdgcn_sched_barrier(0); }
            AT_MASK(1);
            AT_REF(1);
            if (unseen_any) unseen_any = __any(!seen[0] || !seen[1]);
            __builtin_amdgcn_sched_barrier(0);
#pragma unroll
            for (int vt = 0; vt < 8; ++vt) { R.o[0][vt] = mfma16(__builtin_bit_cast(bf16x8, vw[vt]), __builtin_bit_cast(bf16x8, pb[0][0]), R.o[0][vt]); AT_ES(1, vt); __builtin_amdgcn_sched_barrier(0); }
            lacc[0] = mfma16(ones, __builtin_bit_cast(bf16x8, pb[0][0]), lacc[0]);
#pragma unroll
            for (int vt = 0; vt < 8; ++vt) R.o[1][vt] = mfma16(__builtin_bit_cast(bf16x8, vw[vt]), __builtin_bit_cast(bf16x8, pb[1][0]), R.o[1][vt]);
            lacc[1] = mfma16(ones, __builtin_bit_cast(bf16x8, pb[1][0]), lacc[1]);
#pragma unroll
            for (int kk = 1; kk < NKT / 2; ++kk) {
                __builtin_amdgcn_sched_barrier(0);
#pragma unroll
                for (int vt = 0; vt < 8; ++vt) { const int c_ = 4 * gk + 4 * kk + lq, s_ = (lr >> 1) & 7; vw[vt] = *(const LAS u32x4*)(vl + (vt * 16 + lr) * 128 + ((c_ ^ s_) << 4)); }
                __builtin_amdgcn_sched_barrier(0);
#pragma unroll
                for (int vt = 0; vt < 8; ++vt) {
                    R.o[0][vt] = mfma16(__builtin_bit_cast(bf16x8, vw[vt]), __builtin_bit_cast(bf16x8, pb[0][kk]), R.o[0][vt]);
                    R.o[1][vt] = mfma16(__builtin_bit_cast(bf16x8, vw[vt]), __builtin_bit_cast(bf16x8, pb[1][kk]), R.o[1][vt]); }
                lacc[0] = mfma16(ones, __builtin_bit_cast(bf16x8, pb[0][kk]), lacc[0]); lacc[1] = mfma16(ones, __builtin_bit_cast(bf16x8, pb[1][kk]), lacc[1]); }
#undef AT_MASK
#undef AT_REF
#undef AT_ES
        }
    }
#undef AT_DMA
    R.l[0] = lacc[0][0]; R.l[1] = lacc[1][0];
}
__device__ __forceinline__ void at_put(LAS unsigned char* slot, const AttnOut& R, int lr, int lq) {
    LAS float* xo = (LAS float*)slot; LAS float* xm = xo + 128 * 32;
#pragma unroll
    for (int rt = 0; rt < 2; ++rt) {
#pragma unroll
        for (int vt = 0; vt < 8; ++vt)
#pragma unroll
            for (int r = 0; r < 4; ++r) xo[(vt * 16 + 4 * lq + r) * 32 + rt * 16 + lr] = R.o[rt][vt][r];
        if (lq == 0) { xm[rt * 16 + lr] = R.m[rt]; xm[32 + rt * 16 + lr] = R.l[rt]; } }
}
__device__ __forceinline__ void at_merge(const LAS unsigned char* slot, AttnOut& R, int lr, int lq) {
    const LAS float* xo = (const LAS float*)slot; const LAS float* xm = xo + 128 * 32;
#pragma unroll
    for (int rt = 0; rt < 2; ++rt) { const float m1 = xm[rt * 16 + lr], l1 = xm[32 + rt * 16 + lr];
        const float mn = fmaxf(R.m[rt], m1), a0 = __builtin_amdgcn_exp2f(R.m[rt] - mn), a1 = __builtin_amdgcn_exp2f(m1 - mn);
        R.m[rt] = mn; R.l[rt] = R.l[rt] * a0 + l1 * a1;
#pragma unroll
        for (int vt = 0; vt < 8; ++vt)
#pragma unroll
            for (int r = 0; r < 4; ++r) R.o[rt][vt][r] = R.o[rt][vt][r] * a0 + xo[(vt * 16 + 4 * lq + r) * 32 + rt * 16 + lr] * a1; }
}

constexpr int AT_XH_BYTES = 64 * 32 * 4 + 256;
static_assert(8 * AT_XH_BYTES <= MISC_OFF, "attention LDS (half exchange)");
template <int VT0  >
__device__ __forceinline__ void at_put_half(LAS unsigned char* slot, const AttnOut& R, int lr, int lq) {
    LAS float* xo = (LAS float*)slot; LAS float* xm = xo + 64 * 32;
#pragma unroll
    for (int rt = 0; rt < 2; ++rt) {
#pragma unroll
        for (int v4 = 0; v4 < 4; ++v4)
#pragma unroll
            for (int r = 0; r < 4; ++r) xo[(v4 * 16 + 4 * lq + r) * 32 + rt * 16 + lr] = R.o[rt][VT0 + v4][r];
        if (lq == 0) { xm[rt * 16 + lr] = R.m[rt]; xm[32 + rt * 16 + lr] = R.l[rt]; } }
}
template <int VT0  >
__device__ __forceinline__ void at_merge_half(const LAS unsigned char* slot, AttnOut& R, int lr, int lq) {
    const LAS float* xo = (const LAS float*)slot; const LAS float* xm = xo + 64 * 32;
#pragma unroll
    for (int rt = 0; rt < 2; ++rt) { const float m1 = xm[rt * 16 + lr], l1 = xm[32 + rt * 16 + lr];
        const float mn = fmaxf(R.m[rt], m1), a0 = __builtin_amdgcn_exp2f(R.m[rt] - mn), a1 = __builtin_amdgcn_exp2f(m1 - mn);
        R.m[rt] = mn; R.l[rt] = R.l[rt] * a0 + l1 * a1;
#pragma unroll
        for (int v4 = 0; v4 < 4; ++v4)
#pragma unroll
            for (int r = 0; r < 4; ++r) R.o[rt][VT0 + v4][r] = R.o[rt][VT0 + v4][r] * a0 + xo[(v4 * 16 + 4 * lq + r) * 32 + rt * 16 + lr] * a1; }
}
struct NsaPre { float gl[2]; f32x4 yw[2][4], yc[2][4]; };
template <int MODE>
__device__ __forceinline__ void nsa_pre(unsigned char* ws, NsaPre& Q, int b, int h, int wq0, int lr, int lq, int vt0) {
    const float* GT = (const float*)(ws + WS_GT); const float* YW = (const float*)(ws + WS_YW); const float* YCM = (const float*)(ws + WS_YCM);
#pragma unroll
    for (int rt = 0; rt < 2; ++rt) { const size_t row = (size_t)b * NT + wq0 + rt * 16 + lr;
        Q.gl[rt] = GT[row * 32 + 3 * h + (MODE == MODE_WIN ? 2 : 1)];
        if (MODE != MODE_WIN) {
#pragma unroll
            for (int v4 = 0; v4 < 4; ++v4) { const size_t ci = row * 768 + h * 128 + (vt0 + v4) * 16 + 4 * lq; Q.yw[rt][v4] = *(const f32x4*)(YW + ci); Q.yc[rt][v4] = *(const f32x4*)(YCM + ci); } } }
}
template <int MODE, int VT0>
__device__ __forceinline__ void nsa_out(unsigned char* ws, AttnOut& R, const NsaPre& Q, int b, int h, int wq0, int lr, int lq) {
    float* YW = (float*)(ws + WS_YW); bf16* Y = (bf16*)(ws + WS_Y);
#pragma unroll
    for (int rt = 0; rt < 2; ++rt) { const int pos = wq0 + rt * 16 + lr; const size_t row = (size_t)b * NT + pos;
        float a = 1.f;
        if (MODE == MODE_WIN) {
            if (pos < 511) { const float mn = fmaxf(R.m[rt], 0.f); a = __builtin_amdgcn_exp2f(R.m[rt] - mn);
                R.l[rt] = R.l[rt] * a + (float)(511 - pos) * __builtin_amdgcn_exp2f(-mn); } }
        const float gl = Q.gl[rt], gs = (MODE == MODE_WIN ? PROBE_WIN : PROBE_SEL) / (1.f + __expf(-gl)), sc = gs * a / R.l[rt];
#pragma unroll
        for (int v4 = 0; v4 < 4; ++v4) { const int vt = VT0 + v4; const size_t ci = row * 768 + h * 128 + vt * 16 + 4 * lq;
            if (MODE == MODE_WIN) *(f32x4*)(YW + ci) = R.o[rt][vt] * sc;
            else { const f32x4 t = Q.yw[rt][v4] + Q.yc[rt][v4] + R.o[rt][vt] * sc;
                u32x2 w; w.x = pg8::cvt_pk_bf16(t[0], t[1]); w.y = pg8::cvt_pk_bf16(t[2], t[3]);
                *(u32x2*)(Y + row * 2048 + 1280 + h * 128 + vt * 16 + 4 * lq) = w; } } }
}

__device__ __forceinline__ void diff_item(const Ctx& C, const Params& p, int l, int item) {
    unsigned char* ws = p.ws; const float* small = (const float*)(ws + WS_SMALL);
    const int qb = 15 - item / 16, bh = item % 16, b = bh >> 2, h = bh & 3;
    const int q0 = qb * 128, c = C.wave >> 2, wr = C.wave & 3, wq0 = q0 + wr * 32;
    const bf16* P = (const bf16*)(ws + WS_P);
    const bf16* Qw = P + (size_t)(HD_AQ + h) * HDSZ + ((size_t)b * NT + wq0) * 128 + 64 * c;
    const bf16* Kp = P + (size_t)(HD_AK + h) * HDSZ + (size_t)b * NT * 128;
    const bf16* VTp = (const bf16*)(ws + WS_VT) + (size_t)(h * 4 + b) * 128 * 2048;
    AttnOut R;
    attn_core<MODE_DIFF, 4>(C, Qw, Kp, VTp, 64 * c, 0, wq0, 0, (q0 + 128) / 64, nullptr, 0.125f * LOG2E, R);
    const int lr = C.lane & 15, lq = C.lane >> 4;
    __syncthreads();
    if (c == 1) at_put(C.lds + wr * AT_X_BYTES, R, lr, lq);
    __syncthreads();
    if (c == 0) {
        const LAS float* xa = (const LAS float*)(C.lds + wr * AT_X_BYTES);
        int ll = l; asm volatile("" : "+s"(ll));
        const float lam = small[ll], osc = 1.f - (0.8f - 0.6f * expf(-0.3f * (float)ll));
        const float* gain = p.da_norm + (size_t)l * 512 + h * 128;
        bf16* Y = (bf16*)(ws + WS_Y);
#pragma unroll
        for (int rt = 0; rt < 2; ++rt) { const int q = rt * 16 + lr;
            const float inv1 = lam / xa[128 * 32 + 32 + q], inv0 = 1.f / R.l[rt];
            f32x4 d[8]; float ss = 0.f;
#pragma unroll
            for (int vt = 0; vt < 8; ++vt)
#pragma unroll
                for (int r = 0; r < 4; ++r) { const int xi = (vt * 16 + 4 * lq + r) * 32 + q; const float dv = R.o[rt][vt][r] * inv0 - xa[xi] * inv1; d[vt][r] = dv; ss += dv * dv; }
            ss += __shfl_xor(ss, 16); ss += __shfl_xor(ss, 32);
            const float rs = rsqrtf(ss * (1.f / 128.f) + EPS) * osc;
            bf16* yr = Y + ((size_t)b * NT + wq0 + q) * 2048 + h * 128 + 4 * lq;
#pragma unroll
            for (int vt = 0; vt < 8; ++vt) { const f32x4 g4 = *(const f32x4*)(gain + vt * 16 + 4 * lq);
                u32x2 w; w.x = pg8::cvt_pk_bf16(d[vt][0] * rs * g4[0], d[vt][1] * rs * g4[1]); w.y = pg8::cvt_pk_bf16(d[vt][2] * rs * g4[2], d[vt][3] * rs * g4[3]);
                *(u32x2*)(yr + vt * 16) = w; } }
    }
}
template <int MODE>
__device__ __forceinline__ void nsa_item(const Ctx& C, const Params& p, int item) {
    unsigned char* ws = p.ws;
    const int qb = 15 - item / 24, bh = item % 24, b = bh / 6, h = bh % 6, g = h / 3;
    const int q0 = qb * 128, gk = C.wave >> 2, wr = C.wave & 3, wq0 = q0 + wr * 32;
    const bf16* P = (const bf16*)(ws + WS_P);
    const bf16* Qw = P + (size_t)(HD_CQ + h) * HDSZ + ((size_t)b * NT + wq0) * 128;
    const bf16* Kp = P + (size_t)((MODE == MODE_WIN ? HD_CKW : HD_CKS) + g) * HDSZ + (size_t)b * NT * 128;
    const bf16* VTp = (const bf16*)(ws + WS_VT) + (size_t)(((MODE == MODE_WIN ? 6 : 4) + g) * 4 + b) * 128 * 2048;
    const unsigned* selm = (const unsigned*)(ws + WS_SELM) + (size_t)(b * 2 + g) * NT;
    int j_lo = 0; if (MODE == MODE_WIN) { const int lo = q0 - 511; j_lo = lo > 0 ? lo / 64 : 0; }
    AttnOut R;
    attn_core<MODE, 2>(C, Qw, Kp, VTp, 0, gk, wq0, j_lo, (q0 + 128) / 64, selm, 0.08838834764831845f * LOG2E, R);
    const int lr = C.lane & 15, lq = C.lane >> 4;
    NsaPre Qp; nsa_pre<MODE>(ws, Qp, b, h, wq0, lr, lq, 4 * gk);
    LDS_BARRIER();
    if (gk == 0) at_put_half<4>(C.lds + C.wave * AT_XH_BYTES, R, lr, lq); else at_put_half<0>(C.lds + C.wave * AT_XH_BYTES, R, lr, lq);
    LDS_BARRIER();
    if (gk == 0) { at_merge_half<0>(C.lds + (C.wave ^ 4) * AT_XH_BYTES, R, lr, lq); nsa_out<MODE, 0>(ws, R, Qp, b, h, wq0, lr, lq); }
    else { at_merge_half<4>(C.lds + (C.wave ^ 4) * AT_XH_BYTES, R, lr, lq); nsa_out<MODE, 4>(ws, R, Qp, b, h, wq0, lr, lq); }
}

constexpr int CM_LD = 136, CM_K_OFF = 0, CM_V_OFF = 128 * CM_LD * 2, CM_W_OFF = 2 * 128 * CM_LD * 2, CM_W_BYTES = 16 * CM_LD * 2 + 2048;
static_assert(16 * CM_LD * 2 >= 2 * 16 * 32 * 4 && CM_W_OFF + 8 * CM_W_BYTES <= MISC_OFF, "cmp LDS");
__device__ __forceinline__ void cmp_item(const Ctx& C, const Params& p, int item) {
    unsigned char* ws = p.ws;
    const int rt = item & 1, qb = (item >> 1) & 7, bg = item >> 4, b = bg >> 1, g = bg & 1;
    const int lane = C.lane, lr = lane & 15, lq = lane >> 4, tid = C.tid;
    LAS unsigned char* lds = C.lds;
    const bf16* KC = (const bf16*)(ws + WS_KC) + (size_t)bg * 128 * 128; const bf16* VCT = (const bf16*)(ws + WS_KC) + (size_t)(8 + bg) * 128 * 128;
    for (int c = tid; c < 2048; c += 512) { const int row = c >> 4, ch = (c & 15) * 8;
        *(LAS u32x4*)(lds + CM_K_OFF + (row * CM_LD + ch) * 2) = *(const u32x4*)(KC + row * 128 + ch);
        *(LAS u32x4*)(lds + CM_V_OFF + (row * CM_LD + ch) * 2) = *(const u32x4*)(VCT + row * 128 + ch); }
    __syncthreads();
    const bf16* P = (const bf16*)(ws + WS_P);
    const float* GT = (const float*)(ws + WS_GT); float* YC = (float*)(ws + WS_YCM);
    unsigned* SELM = (unsigned*)(ws + WS_SELM) + (size_t)bg * NT;
    LAS unsigned char* pw = lds + CM_W_OFF + C.wave * CM_W_BYTES;
    LAS float* gsum = (LAS float*)pw; LAS float* glast = gsum + 16 * 32; LAS float* scr = (LAS float*)(pw + 16 * CM_LD * 2);
    const float c2 = 0.08838834764831845f * LOG2E;
    {
        const int t0 = qb * 256 + C.wave * 32 + rt * 16;
        f32x4 psum[8];
#pragma unroll
        for (int kt = 0; kt < 8; ++kt) psum[kt] = (f32x4){0.f, 0.f, 0.f, 0.f};
        bf16x8 qfa[3][4]; float gla[3][4];
#pragma unroll
        for (int jh = 0; jh < 3; ++jh) { const bf16* Qw_ = P + (size_t)(HD_CQ + g * 3 + jh) * HDSZ + ((size_t)b * NT + t0) * 128;
#pragma unroll
            for (int ks = 0; ks < 4; ++ks) qfa[jh][ks] = *(const bf16x8*)(Qw_ + (size_t)lr * 128 + ks * 32 + 8 * lq);
#pragma unroll
            for (int r = 0; r < 4; ++r) gla[jh][r] = GT[((size_t)b * NT + t0 + 4 * lq + r) * 32 + 3 * (g * 3 + jh) + 0]; }
#pragma unroll
        for (int jh = 0; jh < 3; ++jh) {
            const int h = g * 3 + jh;
            bf16x8 qf[4];
#pragma unroll
            for (int ks = 0; ks < 4; ++ks) qf[ks] = qfa[jh][ks];
            f32x4 s[8];
#pragma unroll
            for (int kt = 0; kt < 8; ++kt) s[kt] = (f32x4){0.f, 0.f, 0.f, 0.f};
#pragma unroll
            for (int ks = 0; ks < 4; ++ks) { bf16x8 kf[8];
#pragma unroll
                for (int kt = 0; kt < 8; ++kt) kf[kt] = *(const LAS bf16x8*)(lds + CM_K_OFF + ((kt * 16 + lr) * CM_LD + ks * 32 + 8 * lq) * 2);
                __builtin_amdgcn_sched_barrier(0);
#pragma unroll
                for (int kt = 0; kt < 8; ++kt) s[kt] = mfma16(qf[ks], kf[kt], s[kt]);
                __builtin_amdgcn_sched_barrier(0); }
#pragma unroll
            for (int r = 0; r < 4; ++r) {
                const int pos = t0 + 4 * lq + r;
                float mx = -__builtin_inff();
#pragma unroll
                for (int kt = 0; kt < 8; ++kt) { const int n = kt * 16 + lr; const bool ok = (16 * n + 31 <= pos) && (n < 127); const float v = ok ? s[kt][r] : -__builtin_inff(); s[kt][r] = v; mx = fmaxf(mx, v); }
                mx = row16_max(mx);
                if (mx == -__builtin_inff()) mx = 0.f;
                float ps = 0.f;
#pragma unroll
                for (int kt = 0; kt < 8; ++kt) { const float pv = __builtin_amdgcn_exp2f(s[kt][r] - mx); s[kt][r] = pv; ps += pv; }
                ps = row16_sum(ps);
                const float inv = 1.f / fmaxf(ps, 1e-30f);
#pragma unroll
                for (int kt = 0; kt < 8; ++kt) { const float pv = s[kt][r] * inv; psum[kt][r] += pv; *(LAS unsigned short*)(pw + ((4 * lq + r) * CM_LD + kt * 16 + lr) * 2) = (unsigned short)f2bf(pv); }
            }
            LDS_WAIT();
            f32x4 o[8];
#pragma unroll
            for (int vt = 0; vt < 8; ++vt) o[vt] = (f32x4){0.f, 0.f, 0.f, 0.f};
#pragma unroll
            for (int kk = 0; kk < 4; ++kk) { const bf16x8 pf = *(const LAS bf16x8*)(pw + (lr * CM_LD + kk * 32 + 8 * lq) * 2); bf16x8 vf[8];
#pragma unroll
                for (int vt = 0; vt < 8; ++vt) vf[vt] = *(const LAS bf16x8*)(lds + CM_V_OFF + ((vt * 16 + lr) * CM_LD + kk * 32 + 8 * lq) * 2);
                __builtin_amdgcn_sched_barrier(0);
#pragma unroll
                for (int vt = 0; vt < 8; ++vt) o[vt] = mfma16(pf, vf[vt], o[vt]);
                __builtin_amdgcn_sched_barrier(0); }
#pragma unroll
            for (int r = 0; r < 4; ++r) { const size_t row = (size_t)b * NT + t0 + 4 * lq + r;
                const float gl = gla[jh][r], gs = PROBE_CMP / (1.f + __expf(-gl));
#pragma unroll
                for (int vt = 0; vt < 8; ++vt) { const size_t ci = row * 768 + h * 128 + vt * 16 + lr; YC[ci] = o[vt][r] * gs; } }
            LDS_WAIT();
        }
#pragma unroll
        for (int kt = 0; kt < 8; ++kt)
#pragma unroll
            for (int r = 0; r < 4; ++r) { float v = psum[kt][r]; const float own = v; v += __shfl_xor(v, 1); v += __shfl_xor(v, 2);
                const int q = kt * 4 + (lr >> 2), row = 4 * lq + r;
                if ((lr & 3) == 0) gsum[row * 32 + q] = v;
                if ((lr & 3) == 3) glast[row * 32 + q] = own; }
        LDS_WAIT();
        unsigned mymask[8];
#pragma unroll
        for (int it = 0; it < 8; ++it) { const int row = it * 2 + (lane >> 5), sblk = lane & 31, pos = t0 + row, cur = pos >> 6;
            float imp = gsum[row * 32 + sblk]; if (sblk > 0) imp += glast[row * 32 + sblk - 1];
            const bool valid = sblk <= cur, forced = (sblk == 0) || (sblk == cur) || (sblk == cur - 1);
            const float sc = valid ? imp + (forced ? 1.0e4f : 0.f) : -__builtin_inff();
            scr[row * 32 + sblk] = sc;
            LDS_WAIT();
            int cnt = 0;
            for (int s2 = 0; s2 < 32; ++s2) { const float o2 = scr[row * 32 + s2]; cnt += (o2 > sc || (o2 == sc && s2 < sblk)) ? 1 : 0; }
            const unsigned long long bal = __ballot(valid && cnt < 16);
            mymask[it] = (lane >> 5) ? (unsigned)(bal >> 32) : (unsigned)bal; }
#pragma unroll
        for (int it = 0; it < 8; ++it) if ((lane & 31) == 0) SELM[t0 + it * 2 + (lane >> 5)] = mymask[it];
        LDS_WAIT();
    }
}

__device__ __forceinline__ void c2_task(const Ctx& C, const Params& p, int l, int task) {
    unsigned char* ws = p.ws;
    const int nb = task & 7, g = (task >> 3) & 1, b = (task >> 4) & 3, kv = task >> 6;
    const float* HC = (const float*)(ws + WS_HC); const float* pbp = (const float*)(ws + WS_SMALL) + 8192 + (size_t)(l * 2 + kv) * 32 * 256;
    LAS float* pb = (LAS float*)(C.lds + 16384);
    if (C.tid < 256) { float a = 0.f; for (int sl = 0; sl < 32; ++sl) a += pbp[sl * 256 + C.tid]; pb[C.tid] = a; }
    LDS_BARRIER();
    const bf16* W2T = (const bf16*)(ws + WS_W + (size_t)l * WL_SZ + WL_W2) + (size_t)kv * 128 * 256;
    LAS bf16* hid = (LAS bf16*)C.lds;
    const int rbase = kv * 1024 + g * 512 + b * 128;
    for (int e = C.tid; e < 16 * 256; e += 512) { const int i = e >> 8, c = e & 255, n = nb * 16 + i;
        float v = 0.f;
        if (n < 127) { const float x = HC[(size_t)(rbase + n) * 512 + c] + HC[(size_t)(rbase + n + 1) * 512 + 256 + c] + pb[c];
            v = 0.5f * x * (1.f + tanhf(0.7978845608028654f * (x + 0.044715f * x * x * x))); }
        hid[i * 264 + c] = (bf16)f2bf(v); }
    LDS_BARRIER();
    const int lr = C.lane & 15, lq = C.lane >> 4, dt = C.wave;
    f32x4 acc = (f32x4){0.f, 0.f, 0.f, 0.f};
#pragma unroll
    for (int ks = 0; ks < 8; ++ks) acc = mfma16(*(const LAS bf16x8*)(hid + lr * 264 + ks * 32 + 8 * lq), *(const bf16x8*)(W2T + (size_t)(dt * 16 + lr) * 256 + ks * 32 + 8 * lq), acc);
    bf16* KC = (bf16*)(ws + WS_KC) + (size_t)(b * 2 + g) * 128 * 128; bf16* VCT = (bf16*)(ws + WS_KC) + (size_t)(8 + b * 2 + g) * 128 * 128;
#pragma unroll
    for (int r = 0; r < 4; ++r) { const int n = nb * 16 + 4 * lq + r, d = dt * 16 + lr; const bf16 v = (bf16)f2bf(acc[r]);
        if (kv == 0) KC[n * 128 + d] = v; else VCT[d * 128 + n] = v; }
    LDS_BARRIER();
}

constexpr int HG_TOT = 0, HG_ECM = 2048, HG_RED = 2560, HG_LD = 136, HG_SLD = 72;
constexpr int HG_QM = 4096, HG_KM = HG_QM + 64 * HG_LD * 2, HG_SC = HG_KM + 64 * HG_LD * 2, HG_VT = HG_SC + 64 * HG_SLD * 2, HG_SP = HG_VT + 128 * HG_SLD * 2, HG_END = HG_SP + 128 * HG_LD * 2;
static_assert(HG_END <= MISC_OFF, "HGRN LDS");
__device__ __forceinline__ u32x4 pack8u(const unsigned short* v) { u32x4 w; w.x = v[0] | ((unsigned)v[1] << 16); w.y = v[2] | ((unsigned)v[3] << 16); w.z = v[4] | ((unsigned)v[5] << 16); w.w = v[6] | ((unsigned)v[7] << 16); return w; }
__device__ __forceinline__ void hg1_task(const Ctx& C, const Params& p, int task) {
    unsigned char* ws = p.ws;
    const int n = task & 31, bh = task >> 5, b = bh / 6, h = bh % 6;
    const size_t row0 = (size_t)b * NT + n * 64;
    const bf16* P = (const bf16*)(ws + WS_P);
    const int seg = C.tid >> 7, k = C.tid & 127;
    const float* lf = (const float*)(ws + WS_LF) + ((size_t)h * NM + row0 + seg * 16) * 128 + k;
    const bf16* kp = P + (size_t)(HD_BF + h) * HDSZ + (row0 + seg * 16) * 128 + k; const bf16* ip = P + (size_t)(HD_BI + h) * HDSZ + (row0 + seg * 16) * 128 + k;
    float c[16]; unsigned short kr[16], ir[16];
#pragma unroll
    for (int i = 0; i < 16; ++i) { c[i] = lf[i * 128]; kr[i] = kp[i * 128]; ir[i] = ip[i * 128]; }
#pragma unroll
    for (int i = 1; i < 16; ++i) c[i] += c[i - 1];
    LAS float* tot = (LAS float*)(C.lds + HG_TOT);
    LAS bf16* KT = (LAS bf16*)(C.lds + HG_SP); LAS bf16* VT = (LAS bf16*)(C.lds + HG_VT);
    tot[seg * 128 + k] = c[15];
    LDS_BARRIER();
    const float t0 = tot[k], t1 = tot[128 + k], t2 = tot[256 + k], t3 = tot[384 + k];
    const float off = (seg > 0 ? t0 : 0.f) + (seg > 1 ? t1 : 0.f) + (seg > 2 ? t2 : 0.f), last = ((t0 + t1) + t2) + t3;
    unsigned short kw[16];
#pragma unroll
    for (int i = 0; i < 16; ++i) kw[i] = (unsigned short)f2bf(bf2f(kr[i]) * __expf(last - (c[i] + off)));
    *(LAS u32x4*)(KT + k * HG_SLD + seg * 16) = pack8u(kw); *(LAS u32x4*)(KT + k * HG_SLD + seg * 16 + 8) = pack8u(kw + 8);
    *(LAS u32x4*)(VT + k * HG_SLD + seg * 16) = pack8u(ir); *(LAS u32x4*)(VT + k * HG_SLD + seg * 16 + 8) = pack8u(ir + 8);
    if (seg == 0) ((float*)(ws + WS_DEC))[(size_t)task * 128 + k] = __expf(last);
    LDS_BARRIER();
    const int lr = C.lane & 15, lq = C.lane >> 4, vt = C.wave;
    float* DS = (float*)(ws + WS_DS) + (size_t)task * 128 * 128;
    bf16x8 af[2];
#pragma unroll
    for (int ks = 0; ks < 2; ++ks) af[ks] = *(const LAS bf16x8*)(VT + (vt * 16 + lr) * HG_SLD + ks * 32 + 8 * lq);
    bf16x8 kfr[8][2];
#pragma unroll
    for (int kt = 0; kt < 8; ++kt)
#pragma unroll
        for (int ks = 0; ks < 2; ++ks) kfr[kt][ks] = *(const LAS bf16x8*)(KT + (kt * 16 + lr) * HG_SLD + ks * 32 + 8 * lq);
    __builtin_amdgcn_sched_barrier(0);
#pragma unroll
    for (int kt = 0; kt < 8; ++kt) { f32x4 acc = (f32x4){0.f, 0.f, 0.f, 0.f};
#pragma unroll
        for (int ks = 0; ks < 2; ++ks) acc = mfma16(kfr[kt][ks], af[ks], acc);
        *(f32x4*)(DS + (size_t)(vt * 16 + lr) * 128 + kt * 16 + 4 * lq) = acc; }
    LDS_BARRIER();
}
__device__ __forceinline__ void hg2_scan(const Ctx& C, const Params& p) {
    unsigned char* ws = p.ws;
    const float* DS = (const float*)(ws + WS_DS); const float* DEC = (const float*)(ws + WS_DEC); bf16* SP = (bf16*)(ws + WS_SP);
    constexpr int NQ = 24 * 16384 / 4;
    int q = -1, qstep = 0;
    if (C.G == 256) { if (C.bid >= 128) q = (C.bid - 128) * 512 + C.tid; else if (C.tid < 256) q = 65536 + C.bid * 256 + C.tid; qstep = NQ; }
    else { q = C.bid * 512 + C.tid; qstep = C.G * 512; }
    for (; q >= 0 && q < NQ; q += qstep) {
        const int e0 = 4 * q; const size_t t0 = (size_t)(e0 >> 14) * 32; const int k0 = e0 & 16383;
        f32x4 S = (f32x4){0.f, 0.f, 0.f, 0.f};
#pragma unroll 8
        for (int n = 0; n < 32; ++n) {
            const f32x4 d = *(const f32x4*)(DS + (t0 + n) * 16384 + k0), c = *(const f32x4*)(DEC + (t0 + n) * 128 + (k0 & 127));
            u32x2 w; w.x = pk2(S[0], S[1]); w.y = pk2(S[2], S[3]); *(u32x2*)(SP + (t0 + n) * 16384 + k0) = w;
            S = c * S + d; }
    }
}
__device__ __forceinline__ void hg3_task(const Ctx& C, const Params& p, int l, int task) {
    unsigned char* ws = p.ws;
    const int n = task & 31, bh = task >> 5, b = bh / 6, h = bh % 6;
    const size_t row0 = (size_t)b * NT + n * 64;
    const bf16* P = (const bf16*)(ws + WS_P);
    const int seg = C.tid >> 7, k = C.tid & 127;
    const float* lf = (const float*)(ws + WS_LF) + ((size_t)h * NM + row0 + seg * 16) * 128 + k;
    const bf16* kp = P + (size_t)(HD_BF + h) * HDSZ + (row0 + seg * 16) * 128 + k; const bf16* qp = P + (size_t)(HD_BQ + h) * HDSZ + (row0 + seg * 16) * 128 + k;
    const bf16* ip = P + (size_t)(HD_BI + h) * HDSZ + (row0 + seg * 16) * 128 + k; const bf16* gp = P + (size_t)(HD_BG + h) * HDSZ + row0 * 128;
    const bf16* SPg = (const bf16*)(ws + WS_SP) + (size_t)task * 16384;
    float c[16]; unsigned short kr[16], qr[16], ir[16]; bf16x8 spv[4];
#pragma unroll
    for (int i = 0; i < 16; ++i) { c[i] = lf[i * 128]; kr[i] = kp[i * 128]; qr[i] = qp[i * 128]; ir[i] = ip[i * 128]; }
#pragma unroll
    for (int q = 0; q < 4; ++q) { const int e = C.tid + q * 512; spv[q] = *(const bf16x8*)(SPg + (e >> 4) * 128 + (e & 15) * 8); }
#pragma unroll
    for (int i = 1; i < 16; ++i) c[i] += c[i - 1];
    LAS float* tot = (LAS float*)(C.lds + HG_TOT); LAS float* ecm = (LAS float*)(C.lds + HG_ECM); LAS float* red = (LAS float*)(C.lds + HG_RED);
    LAS bf16* QM = (LAS bf16*)(C.lds + HG_QM); LAS bf16* KM = (LAS bf16*)(C.lds + HG_KM); LAS bf16* SPl = (LAS bf16*)(C.lds + HG_SP);
    LAS bf16* SC = (LAS bf16*)(C.lds + HG_SC); LAS bf16* VT = (LAS bf16*)(C.lds + HG_VT);
    tot[seg * 128 + k] = c[15];
    LDS_BARRIER();
    unsigned short ggr[4][4]; float gnr[4];
    { const int lr_ = C.lane & 15, lq_ = C.lane >> 4, tt_ = C.wave & 3, vh_ = C.wave >> 2; const float* gain_ = p.hg_norm + (size_t)l * 768 + h * 128;
#pragma unroll
      for (int r = 0; r < 4; ++r)
#pragma unroll
        for (int q = 0; q < 4; ++q) ggr[r][q] = gp[(size_t)(tt_ * 16 + 4 * lq_ + r) * 128 + (vh_ * 4 + q) * 16 + lr_];
#pragma unroll
      for (int q = 0; q < 4; ++q) gnr[q] = gain_[(vh_ * 4 + q) * 16 + lr_]; }
    { const float t0 = tot[k], t1 = tot[128 + k], t2 = tot[256 + k];
      const float off = (seg > 0 ? t0 : 0.f) + (seg > 1 ? t1 : 0.f) + (seg > 2 ? t2 : 0.f), cm = t0 + t1;
#pragma unroll
      for (int i = 0; i < 16; ++i) { const float d = (c[i] + off) - cm; const int t = seg * 16 + i;
          QM[t * HG_LD + k] = (bf16)f2bf(bf2f(qr[i]) * __expf(d)); KM[t * HG_LD + k] = (bf16)f2bf(bf2f(kr[i]) * __expf(-d)); }
      *(LAS u32x4*)(VT + k * HG_SLD + seg * 16) = pack8u(ir); *(LAS u32x4*)(VT + k * HG_SLD + seg * 16 + 8) = pack8u(ir + 8);
      if (seg == 0) ecm[k] = __expf(cm); }
    LDS_BARRIER();
    const int lr = C.lane & 15, lq = C.lane >> 4;
    { const int tt = C.wave >> 1;
        bf16x8 af[4];
#pragma unroll
        for (int ks = 0; ks < 4; ++ks) af[ks] = *(const LAS bf16x8*)(QM + (tt * 16 + lr) * HG_LD + ks * 32 + 8 * lq);
#pragma unroll
        for (int q = 0; q < 2; ++q) { const int st = (C.wave & 1) * 2 + q; f32x4 acc = (f32x4){0.f, 0.f, 0.f, 0.f};
            bf16x8 kf4[4];
#pragma unroll
            for (int ks = 0; ks < 4; ++ks) kf4[ks] = *(const LAS bf16x8*)(KM + (st * 16 + lr) * HG_LD + ks * 32 + 8 * lq);
            __builtin_amdgcn_sched_barrier(0);
#pragma unroll
            for (int ks = 0; ks < 4; ++ks) acc = mfma16(af[ks], kf4[ks], acc);
#pragma unroll
            for (int r = 0; r < 4; ++r) { const int t = tt * 16 + 4 * lq + r, s = st * 16 + lr; SC[t * HG_SLD + s] = (bf16)f2bf(s <= t ? acc[r] : 0.f); } } }
#pragma unroll
    for (int q = 0; q < 4; ++q) { const int e = C.tid + q * 512, v = e >> 4, k0 = (e & 15) * 8; unsigned short w[8];
#pragma unroll
        for (int j = 0; j < 8; ++j) w[j] = (unsigned short)f2bf(bf2f((unsigned short)spv[q][j]) * ecm[k0 + j]);
        *(LAS u32x4*)(SPl + v * HG_LD + k0) = pack8u(w); }
    LDS_BARRIER();
    const int tt = C.wave & 3, vh = C.wave >> 2;
    f32x4 o[4];
#pragma unroll
    for (int q = 0; q < 4; ++q) o[q] = (f32x4){0.f, 0.f, 0.f, 0.f};
    {
        bf16x8 a2[2], vf2[2][4];
#pragma unroll
        for (int ks = 0; ks < 2; ++ks) { a2[ks] = *(const LAS bf16x8*)(SC + (tt * 16 + lr) * HG_SLD + ks * 32 + 8 * lq);
#pragma unroll
            for (int q = 0; q < 4; ++q) vf2[ks][q] = *(const LAS bf16x8*)(VT + ((vh * 4 + q) * 16 + lr) * HG_SLD + ks * 32 + 8 * lq); }
        __builtin_amdgcn_sched_barrier(0);
#pragma unroll
        for (int ks = 0; ks < 2; ++ks)
#pragma unroll
            for (int q = 0; q < 4; ++q) o[q] = mfma16(a2[ks], vf2[ks][q], o[q]);
        __builtin_amdgcn_sched_barrier(0);
#pragma unroll
        for (int kh = 0; kh < 2; ++kh) { bf16x8 a4[2], sf[2][4];
#pragma unroll
            for (int k2 = 0; k2 < 2; ++k2) { const int ks = 2 * kh + k2; a4[k2] = *(const LAS bf16x8*)(QM + (tt * 16 + lr) * HG_LD + ks * 32 + 8 * lq);
#pragma unroll
                for (int q = 0; q < 4; ++q) sf[k2][q] = *(const LAS bf16x8*)(SPl + ((vh * 4 + q) * 16 + lr) * HG_LD + ks * 32 + 8 * lq); }
            __builtin_amdgcn_sched_barrier(0);
#pragma unroll
            for (int k2 = 0; k2 < 2; ++k2)
#pragma unroll
                for (int q = 0; q < 4; ++q) o[q] = mfma16(a4[k2], sf[k2][q], o[q]);
            __builtin_amdgcn_sched_barrier(0); }
    }
    float gg[4][4];
#pragma unroll
    for (int r = 0; r < 4; ++r)
#pragma unroll
        for (int q = 0; q < 4; ++q) gg[r][q] = bf2f(ggr[r][q]);
#pragma unroll
    for (int r = 0; r < 4; ++r) { float ss = 0.f;
#pragma unroll
        for (int q = 0; q < 4; ++q) ss += o[q][r] * o[q][r];
        ss = row16_sum(ss);
        if (lr == 0) red[(tt * 16 + 4 * lq + r) * 2 + vh] = ss; }
    LDS_BARRIER();
    bf16* Y = (bf16*)(ws + WS_Y); LAS bf16* Tw = (LAS bf16*)(C.lds + HG_QM) + C.wave * (16 * 72);
#pragma unroll
    for (int r = 0; r < 4; ++r) { const int t = tt * 16 + 4 * lq + r; const float rs = rsqrtf((red[t * 2] + red[t * 2 + 1]) * (1.f / 128.f) + EPS);
#pragma unroll
        for (int q = 0; q < 4; ++q) { const float g1 = gg[r][q];
            Tw[(4 * lq + r) * 72 + q * 16 + lr] = (bf16)f2bf(o[q][r] * rs * gnr[q] * (g1 / (1.f + __expf(-g1)))); } }
    LDS_WAIT();
#pragma unroll
    for (int i = 0; i < 2; ++i) { const int ri = (C.lane >> 3) + 8 * i, ci = C.lane & 7;
        *(u32x4*)(Y + (row0 + tt * 16 + ri) * 2048 + 512 + h * 128 + vh * 64 + ci * 8) = *(const LAS u32x4*)(Tw + ri * 72 + ci * 8); }
    LDS_BARRIER();
}

constexpr int NPH = 2 + 8 * NL;
#ifndef MK_PER_PHASE
#define MK_PER_PHASE 0
#endif

__global__ void __launch_bounds__(512, 2) hymba_fwd(Params p) {
    extern __shared__ __attribute__((aligned(16))) unsigned char lds_raw[];
    Ctx C;
    C.lds = (LAS unsigned char*)lds_raw;
    C.tid = threadIdx.x; C.lane = C.tid & 63; C.wave = __builtin_amdgcn_readfirstlane(C.tid >> 6); C.bid = blockIdx.x; C.G = gridDim.x;
    unsigned char* ws = p.ws;
    C.ctl = (unsigned*)(ws + WS_CTL);
    volatile LAS unsigned* misc = (volatile LAS unsigned*)(C.lds + MISC_OFF);
    if (C.tid < 8) misc[C.tid] = 0u;
    __syncthreads();
    const int lo = p.ph_lo, hi = p.ph_hi;
    XcdBarrier bar; bar.bar = C.ctl + CW_BAR; bar.x = 0; bar.st = misc;
    if (hi - lo > 1) bar = xcd_barrier_post(C.ctl + CW_BAR, misc);
#define PH_ON(k) (lo <= (k) && (k) < hi)
#define PH_FRESH() do { int t_ = threadIdx.x, b_ = blockIdx.x; asm volatile("" : "+v"(t_)); asm volatile("" : "+s"(b_)); C.tid = t_; C.lane = t_ & 63; C.wave = __builtin_amdgcn_readfirstlane(t_ >> 6); C.bid = b_; } while (0)
#define PH_SEAM(k) do { if ((k) + 1 < hi) xcd_barrier(bar); } while (0)
#ifndef REP_PRO
#define REP_PRO 1
#endif
#ifndef REP_GEMM
#define REP_GEMM 1
#endif
#ifndef REP_MIX
#define REP_MIX 1
#endif
#ifndef REP_M2
#define REP_M2 1
#endif
#ifndef REP_M3
#define REP_M3 1
#endif
#ifndef REP_M4
#define REP_M4 1
#endif
#ifndef REP_M5
#define REP_M5 1
#endif
#ifndef REP_NORM
#define REP_NORM 1
#endif
#define PH_BEGIN(k, REPN) if (PH_ON(k)) for (int rep = 0; rep < (REPN); ++rep) { PH_FRESH();
#define PH_END(k, REPN) if (rep + 1 < (REPN)) xcd_barrier(bar); else PH_SEAM(k); }

    PH_BEGIN(0, REP_PRO) p0_prologue(C, p); PH_END(0, REP_PRO)

    bf16* XA = (bf16*)(ws + WS_HN); bf16* XB = (bf16*)(ws + WS_XA);
    bf16* Pb = (bf16*)(ws + WS_P); bf16* Yb = (bf16*)(ws + WS_Y); bf16* HF = (bf16*)(ws + WS_HF);
    for (int l = 0; l < NL; ++l) {
        const int k0 = 1 + 8 * l; float* SS = (float*)(ws + WS_SSP);
        unsigned char* wl = ws + WS_W + (size_t)l * WL_SZ;

        unsigned* qc = C.ctl + CW_Q + 512 * (l * 4);
        PH_BEGIN(k0 + 0, REP_GEMM)
            pg8::Gemm g{XA, (const bf16*)(wl + WL_IN), NM, NPAD, ND}; pg8::StaticOrder S; S.init(NM, NPAD, C.G, C.bid);
            LAS float* rtab = (LAS float*)(C.lds + 131072); pg8::Unit u0{0, 0}; (void)S.next(0, u0);
            if (C.tid < 256) rtab[C.tid] = pg8::row_rstd(SS + (size_t)(l * 2) * 8192 * 8, u0.pm * 256 + C.tid);
            __syncthreads();
            pg8::EpiIn E{Pb, (float*)(ws + WS_LF), (float*)(ws + WS_GT), (bf16*)(ws + WS_VT), (const float*)(ws + WS_SMALL) + 4 + l * 768, SS + (size_t)(l * 2) * 8192 * 8, rtab, u0.pm};
            pg8::gemm_phase<pg8::EpiIn, pg8::StaticOrder, true, true>(C.lds, g, S, E);
        PH_END(k0 + 0, REP_GEMM)
        PH_BEGIN(k0 + 1, REP_MIX * REP_M2)
            { pg8::Gemm g{Pb + (size_t)HD_CKC * HDSZ, (const bf16*)(wl + WL_C1), 2048, 1024, 2048}; pg8::CmpOrder S{C.G, C.bid};
              pg8::EpiHc E{(float*)(ws + WS_HC)};
              pg8::gemm_phase<pg8::EpiHc, pg8::CmpOrder, false, true>(C.lds, g, S, E); }
#ifdef PROBE_NOQ16
            if (C.bid >= 16)
#endif
            for (int sub = -1;;) { const int it = q_next(C, qc + 0 + rep, 384 + 768, sub); if (it >= 384 + 768) break; PH_FRESH();
                if (it < 384) nsa_item<MODE_WIN>(C, p, it);
                else hg1_task(C, p, it - 384); }
        PH_END(k0 + 1, REP_MIX * REP_M2)
        PH_BEGIN(k0 + 2, REP_MIX * REP_M3)
            for (int t = C.bid; t < 128; t += C.G) c2_task(C, p, l, t);
            PH_FRESH();
            hg2_scan(C, p);
        PH_END(k0 + 2, REP_MIX * REP_M3)
        PH_BEGIN(k0 + 3, REP_MIX * REP_M4)
            for (int sub = -1;;) { const int it = q_next(C, qc + 512, 128 + 256 + 768, sub); if (it >= 128 + 256 + 768) break; PH_FRESH();
                if (it < 128) cmp_item(C, p, it); else if (it < 384) diff_item(C, p, l, it - 128); else hg3_task(C, p, l, it - 384); }
        PH_END(k0 + 3, REP_MIX * REP_M4)
        PH_BEGIN(k0 + 4, REP_MIX * REP_M5)
            for (int sub = -1;;) { const int it = q_next(C, qc + 1024 + rep, 384, sub); if (it >= 384) break; PH_FRESH(); nsa_item<MODE_SEL>(C, p, it); }
        PH_END(k0 + 4, REP_MIX * REP_M5)
        PH_BEGIN(k0 + 5, REP_GEMM)
            pg8::Gemm g{Yb, (const bf16*)(wl + WL_OUT), NM, ND, ND}; pg8::StaticOrder S; S.init(NM, ND, C.G, C.bid);
            pg8::EpiRes E{XA, XB, SS + (size_t)(l * 2 + 1) * 8192 * 8};
            pg8::gemm_phase<pg8::EpiRes, pg8::StaticOrder, false, true>(C.lds, g, S, E);
        PH_END(k0 + 5, REP_GEMM)
        PH_BEGIN(k0 + 6, REP_GEMM)
            pg8::Gemm g{XB, (const bf16*)(wl + WL_GU), NM, 2 * DFF, ND}; pg8::StaticOrder S; S.init(NM, 2 * DFF, C.G, C.bid);
            LAS float* rtab = (LAS float*)(C.lds + 131072); pg8::Unit u0{0, 0}; (void)S.next(0, u0);
            if (C.tid < 256) rtab[C.tid] = pg8::row_rstd(SS + (size_t)(l * 2 + 1) * 8192 * 8, u0.pm * 256 + C.tid);
            __syncthreads();
            pg8::EpiGU E{HF, SS + (size_t)(l * 2 + 1) * 8192 * 8, rtab, u0.pm};
            pg8::gemm_phase<pg8::EpiGU, pg8::StaticOrder, true, true>(C.lds, g, S, E);
        PH_END(k0 + 6, REP_GEMM)
        PH_BEGIN(k0 + 7, REP_GEMM)
            pg8::Gemm g{HF, (const bf16*)(wl + WL_DN), NM, ND, DFF}; pg8::StaticOrder S; S.init(NM, ND, C.G, C.bid);
            pg8::EpiRes E{XB, XA, SS + (size_t)(l * 2 + 2) * 8192 * 8};
            pg8::gemm_phase<pg8::EpiRes, pg8::StaticOrder, false, true>(C.lds, g, S, E);
        PH_END(k0 + 7, REP_GEMM)
    }
    if (PH_ON(NPH - 1)) { PH_FRESH(); final_norm_rows(C, XA, p.final_norm, p.out); }
#undef PH_ON
#undef PH_SEAM
}

extern "C" void kernel_launch(void* const* d_in, const int* in_sizes, int n_in, void* d_out, int out_size, void* d_ws, size_t ws_size, hipStream_t stream) {
    static int grid = 0;
    if (grid == 0) {
        if (n_in != 22 || out_size != NM * ND || ws_size < WS_END) { fprintf(stderr, "kernel_launch: unexpected shapes (n_in %d out %d ws %zu need %zu)\n", n_in, out_size, ws_size, (size_t)WS_END); grid = -1; return; }
        int dev = 0, cus = 0, per_cu = 0;
        if (hipGetDevice(&dev) != hipSuccess || hipDeviceGetAttribute(&cus, hipDeviceAttributeMultiprocessorCount, dev) != hipSuccess) { grid = -1; return; }
        if (hipFuncSetAttribute((const void*)hymba_fwd, hipFuncAttributeMaxDynamicSharedMemorySize, LDS_BYTES) != hipSuccess) { fprintf(stderr, "kernel_launch: hipFuncSetAttribute failed\n"); grid = -1; return; }
        if (hipOccupancyMaxActiveBlocksPerMultiprocessor(&per_cu, (const void*)hymba_fwd, 512, LDS_BYTES) != hipSuccess || per_cu < 1) fprintf(stderr, "kernel_launch: occupancy query reports %d\n", per_cu);
        (void)hipGetLastError();
        grid = cus;
    }
    if (grid < 0) return;
    (void)hipMemsetAsync((char*)d_ws + WS_CTL, 0, CTL_ZERO_BYTES, stream);
    Params p{};
    p.x = (const float*)d_in[0]; p.attn_norm = (const float*)d_in[1]; p.w_in = (const float*)d_in[2]; p.lq1 = (const float*)d_in[3]; p.lk1 = (const float*)d_in[4];
    p.lq2 = (const float*)d_in[5]; p.lk2 = (const float*)d_in[6]; p.da_norm = (const float*)d_in[7]; p.hg_gamma = (const float*)d_in[8]; p.hg_norm = (const float*)d_in[9];
    p.pe_k = (const float*)d_in[10]; p.pe_v = (const float*)d_in[11]; p.ck_w1 = (const float*)d_in[12]; p.ck_w2 = (const float*)d_in[13]; p.cv_w1 = (const float*)d_in[14];
    p.cv_w2 = (const float*)d_in[15]; p.w_out = (const float*)d_in[16]; p.ffn_norm = (const float*)d_in[17]; p.w_gate = (const float*)d_in[18]; p.w_up = (const float*)d_in[19];
    p.w_down = (const float*)d_in[20]; p.final_norm = (const float*)d_in[21];
    p.out = (float*)d_out; p.ws = (unsigned char*)d_ws;
#if MK_PER_PHASE
    for (int ph = 0; ph < NPH; ++ph) { p.ph_lo = ph; p.ph_hi = ph + 1; hipLaunchKernelGGL(hymba_fwd, dim3(grid), dim3(512), LDS_BYTES, stream, p); }
#else
    p.ph_lo = 0; p.ph_hi = NPH;
    hipLaunchKernelGGL(hymba_fwd, dim3(grid), dim3(512), LDS_BYTES, stream, p);
#endif
    const hipError_t le = hipPeekAtLastError();
    if (le != hipSuccess) fprintf(stderr, "kernel_launch: launch failed: %s\n", hipGetErrorName(le));
}
#ifdef RES_TEST
#define RT_HEAD extern __shared__ __attribute__((aligned(16))) unsigned char lds_raw[]; Ctx C; C.lds = (LAS unsigned char*)lds_raw; C.tid = threadIdx.x; C.lane = C.tid & 63; C.wave = __builtin_amdgcn_readfirstlane(C.tid >> 6); C.bid = blockIdx.x; C.G = gridDim.x; C.ctl = (unsigned*)p.ws; unsigned char* ws = p.ws; (void)ws;
__global__ void __launch_bounds__(512, 2) t_prologue(Params p) { RT_HEAD p0_prologue(C, p); }
__global__ void __launch_bounds__(512, 2) t_norm(Params p) { RT_HEAD norm_rows(C, p.x, p.attn_norm, (bf16*)ws, nullptr); }
__global__ void __launch_bounds__(512, 2) t_gemm_in(Params p) { RT_HEAD pg8::Gemm g{(bf16*)ws, (const bf16*)(ws + 64), NM, NPAD, ND}; pg8::StaticOrder S; S.init(NM, NPAD, C.G, C.bid);
    pg8::EpiIn E{(bf16*)ws, (float*)(ws + WS_LF), (float*)(ws + WS_GT), (bf16*)(ws + WS_VT), (const float*)(ws + WS_SMALL), (const float*)ws, (const LAS float*)C.lds, 0}; pg8::gemm_phase<pg8::EpiIn, pg8::StaticOrder, true, true>(C.lds, g, S, E); }
__global__ void __launch_bounds__(512, 2) t_gemm_res(Params p) { RT_HEAD pg8::Gemm g{(bf16*)ws, (const bf16*)(ws + 64), NM, ND, ND}; pg8::StaticOrder S; S.init(NM, ND, C.G, C.bid);
    pg8::EpiRes E{(bf16*)ws, (bf16*)ws, (float*)ws}; pg8::gemm_phase<pg8::EpiRes, pg8::StaticOrder, false, true>(C.lds, g, S, E); }
__global__ void __launch_bounds__(512, 2) t_gemm_gu(Params p) { RT_HEAD pg8::Gemm g{(bf16*)ws, (const bf16*)(ws + 64), NM, 2 * DFF, ND}; pg8::StaticOrder S; S.init(NM, 2 * DFF, C.G, C.bid);
    pg8::EpiGU E{(bf16*)p.out, (const float*)ws, (const LAS float*)C.lds, 0}; pg8::gemm_phase<pg8::EpiGU, pg8::StaticOrder, true, true>(C.lds, g, S, E); }
__global__ void __launch_bounds__(512, 2) t_gemm_hc(Params p) { RT_HEAD pg8::Gemm g{(bf16*)ws, (const bf16*)(ws + 64), 2048, 1024, 2048}; pg8::CmpOrder S{C.G, C.bid};
    pg8::EpiHc E{(float*)p.out}; pg8::gemm_phase<pg8::EpiHc, pg8::CmpOrder, false, true>(C.lds, g, S, E); }
__global__ void __launch_bounds__(512, 2) t_diff(Params p) { RT_HEAD diff_item(C, p, p.ph_lo, C.bid); }
__global__ void __launch_bounds__(512, 2) t_win(Params p) { RT_HEAD nsa_item<MODE_WIN>(C, p, C.bid); }
__global__ void __launch_bounds__(512, 2) t_sel(Params p) { RT_HEAD nsa_item<MODE_SEL>(C, p, C.bid); }
__global__ void __launch_bounds__(512, 2) t_cmp(Params p) { RT_HEAD cmp_item(C, p, C.bid); }
__global__ void __launch_bounds__(512, 2) t_c2(Params p) { RT_HEAD c2_task(C, p, p.ph_lo, C.bid); }
__global__ void __launch_bounds__(512, 2) t_hg1(Params p) { RT_HEAD hg1_task(C, p, C.bid); }
__global__ void __launch_bounds__(512, 2) t_hg2(Params p) { RT_HEAD hg2_scan(C, p); }
__global__ void __launch_bounds__(512, 2) t_hg3(Params p) { RT_HEAD hg3_task(C, p, p.ph_lo, C.bid); }
#endif
```
